# Optimizing an MI355X kernel written in HIP

```python
import math
import jax
import jax.numpy as jnp
from jax import lax
import numpy as np

D_MODEL = 1024
BATCH = 8
SEQ = 2048
DEPTH = 2

GRID_W = 64
CTX_LEN = 256
EPS = 1e-6
HY_GROUPS = 4
D_HY = 256
HY_ORDER = 2
HY_BANDS = 16
HY_EMB = 1 + 2 * HY_BANDS
HY_FFN = 64
HY_DECAY_TARGET = 1e-2
HY_FAST_DECAY = 0.3
HY_SLOW_DECAY = 1.5
HY_FILTER_SCALE = 0.07
SG_GROUPS = 4
D_SG = 256
SG_GROUP_DIM = D_SG // SG_GROUPS
SG_CHUNK = 128
ATT_HEADS = 4
QK_DIM = 64
V_DIM = 128
D_ATT = ATT_HEADS * V_DIM
ATT_BLOCK = 128
ROPE_PAIRS = QK_DIM // 4
ROPE_BASE = 10000.0
D_MIX = D_HY + D_SG + D_ATT
IN_A = 3 * D_HY
IN_B = 2 * D_SG
IN_C = 2 * ATT_HEADS * 2 * QK_DIM + D_ATT
D_IN = IN_A + IN_B + IN_C
D_FF = 2816

kernel_name = 'hybrid_hyena_gmlp_diffattn_dit_block'


def rmsnorm(x, g):
    xf = x.astype(jnp.float32)
    y = xf * lax.rsqrt(jnp.mean(xf * xf, axis=-1, keepdims=True) + EPS)
    return (y * g.astype(jnp.float32)).astype(x.dtype)


def layernorm(x, g, b):
    xf = x.astype(jnp.float32)
    mu = jnp.mean(xf, axis=-1, keepdims=True)
    var = jnp.mean(jnp.square(xf - mu), axis=-1, keepdims=True)
    y = (xf - mu) * lax.rsqrt(var + EPS)
    return (y * g.astype(jnp.float32) + b.astype(jnp.float32)).astype(x.dtype)


def modulate(h, shift, scale):
    return h * (1.0 + scale) + shift


def dwconv3(x, w, b):
    L = x.shape[1]
    xp = jnp.pad(x, ((0, 0), (1, 1), (0, 0)))
    return xp[:, :L] * w[0] + xp[:, 1:L + 1] * w[1] + xp[:, 2:] * w[2] + b


def hyena_filters(L, w1, b1, w2, b2, w3, freq):
    f32 = jnp.float32
    t = jnp.linspace(0.0, 1.0, L, dtype=f32)[:, None]
    t_r = jnp.arange(L, dtype=f32)[:, None]
    bands = jnp.linspace(1e-4, HY_BANDS - 1, HY_BANDS, dtype=f32)[None, :]
    w = 2.0 * math.pi * t_r / L
    z = jnp.concatenate([t, jnp.cos(bands * w), -jnp.sin(bands * w)], axis=-1)
    fr = freq.astype(f32)
    h = jnp.sin(fr * (z @ w1.astype(f32) + b1.astype(f32)))
    h = jnp.sin(fr * (h @ w2.astype(f32) + b2.astype(f32)))
    h = (h @ w3.astype(f32)).reshape(L, HY_ORDER, 2, D_HY)
    min_decay = math.log(HY_DECAY_TARGET) / HY_SLOW_DECAY
    max_decay = math.log(HY_DECAY_TARGET) / HY_FAST_DECAY
    deltas = jnp.abs(jnp.linspace(min_decay, max_decay, D_HY, dtype=f32))
    h = h * jnp.exp(-t * deltas)[:, None, None, :]
    hf, hb = h[:, :, 0], h[:, :, 1]
    k = jnp.concatenate([hf, jnp.zeros_like(hf[:1]), hb[:0:-1]], axis=0)
    return jnp.fft.rfft(k, axis=0)


def fftconv(u, kf):
    L = u.shape[1]
    U = jnp.fft.rfft(u, n=2 * L, axis=1)
    return jnp.fft.irfft(U * kf[None], n=2 * L, axis=1)[:, :L]


def hyena_mixer(p, conv_w, conv_b, kf, bias):
    p = dwconv3(p, conv_w, conv_b)
    v, x1, x2 = jnp.split(p, 3, axis=-1)
    bias = bias.astype(jnp.float32)
    z = v.astype(jnp.float32)
    z = x1.astype(jnp.float32) * (fftconv(z, kf[:, 0]) + bias[0] * z)
    z = x2.astype(jnp.float32) * (fftconv(z, kf[:, 1]) + bias[1] * z)
    return z.astype(p.dtype)


def sgu_mixer(p, ln_g, ln_b, w_s, b_s):
    B, L, _ = p.shape
    p = jax.nn.gelu(p)
    u, v = jnp.split(p, 2, axis=-1)
    v = layernorm(v.reshape(B, L, SG_GROUPS, SG_GROUP_DIM), ln_g, ln_b)
    v = v.reshape(B, L // SG_CHUNK, SG_CHUNK, SG_GROUPS, SG_GROUP_DIM)
    s = jnp.einsum('gpq,bcqgd->bcpgd', w_s, v) + b_s.T[None, None, :, :, None]
    return u * s.reshape(B, L, D_SG)


def axial_rope_tables(L):
    rows = L // GRID_W
    row = jnp.broadcast_to(jnp.arange(rows, dtype=jnp.float32)[:, None], (rows, GRID_W)).reshape(-1)
    col = jnp.broadcast_to(jnp.arange(GRID_W, dtype=jnp.float32)[None, :], (rows, GRID_W)).reshape(-1)
    inv = ROPE_BASE ** (-jnp.arange(ROPE_PAIRS, dtype=jnp.float32) / ROPE_PAIRS)
    ang = jnp.stack([row[:, None] * inv, col[:, None] * inv], axis=1)
    return jnp.cos(ang), jnp.sin(ang)


def apply_rope(x, cos, sin):
    B, L, H = x.shape[:3]
    xr = x.reshape(B, L, H, 2, 2, 2, ROPE_PAIRS)
    c = cos.astype(x.dtype)[None, :, None, None, :, :]
    s = sin.astype(x.dtype)[None, :, None, None, :, :]
    x1, x2 = xr[..., 0, :], xr[..., 1, :]
    out = jnp.stack([x1 * c - x2 * s, x2 * c + x1 * s], axis=-2)
    return out.reshape(x.shape)


def diff_qkv(pc, qn, kn):
    B, L, _ = pc.shape
    q, k, v = jnp.split(pc, [2 * ATT_HEADS * QK_DIM, 4 * ATT_HEADS * QK_DIM], axis=-1)
    q = rmsnorm(q.reshape(B, L, ATT_HEADS, 2, QK_DIM), qn)
    k = rmsnorm(k.reshape(B, L, ATT_HEADS, 2, QK_DIM), kn)
    return q, k, v.reshape(B, L, ATT_HEADS, V_DIM)


def diff_attend(q, k, v, lam):
    s = jnp.einsum('bqhcd,bkhcd->bhcqk', q, k, preferred_element_type=jnp.float32) * (QK_DIM ** -0.5)
    p = jax.nn.softmax(s, axis=-1)
    a = p[:, :, 0] - lam * p[:, :, 1]
    return jnp.einsum('bhqk,bkhe->bqhe', a.astype(v.dtype), v)


def diff_attention_blocks(q, k, v, lam):
    B, L, H, _, dq = q.shape
    nb = L // ATT_BLOCK
    qb = jnp.moveaxis(q.reshape(B, nb, ATT_BLOCK, H, 2, dq), 1, 0)
    o = lax.map(lambda qq: diff_attend(qq, k, v, lam), qb)
    return jnp.moveaxis(o, 0, 1).reshape(B, L, H, v.shape[-1])


def diff_out(o, g, lam_init):
    B, L = o.shape[:2]
    return (rmsnorm(o, g) * (1.0 - lam_init)).reshape(B, L, D_ATT)


def conv_ffn(h, w_up, cw, cb, w_down):
    u = dwconv3(h @ w_up, cw, cb)
    g, val = jnp.split(u, 2, axis=-1)
    return (jax.nn.silu(g) * val) @ w_down


def setup_inputs(seed: int = 0) -> dict:
    key = jax.random.key(seed)
    ks = iter(jax.random.split(key, 40))

    def nrm(shape, scale):
        return jax.random.normal(next(ks), shape, jnp.float32) * scale

    def gain(shape):
        return 1.0 + nrm(shape, 0.02)

    return {
        'x': nrm((BATCH, SEQ, D_MODEL), 1.0),
        'c': nrm((BATCH, D_MODEL), 1.0),
        'ctx': nrm((BATCH, CTX_LEN, D_MODEL), 1.0),
        'c_ctx': nrm((D_MODEL,), 1.0),
        'w_mod': nrm((DEPTH, D_MODEL, 6 * D_MODEL), 0.5 * D_MODEL ** -0.5),
        'b_mod': nrm((DEPTH, 6 * D_MODEL), 0.02),
        'norm1_g': gain((DEPTH, D_MODEL)),
        'w_in': nrm((DEPTH, D_MODEL, D_IN), D_MODEL ** -0.5),
        'hy_conv_w': nrm((DEPTH, 3, IN_A), 3 ** -0.5),
        'hy_conv_b': nrm((DEPTH, IN_A), 0.02),
        'hy_w1': nrm((DEPTH, HY_EMB, HY_FFN), HY_EMB ** -0.5),
        'hy_b1': nrm((DEPTH, HY_FFN), 0.02),
        'hy_w2': nrm((DEPTH, HY_FFN, HY_FFN), HY_FFN ** -0.5),
        'hy_b2': nrm((DEPTH, HY_FFN), 0.02),
        'hy_w3': nrm((DEPTH, HY_FFN, HY_ORDER * 2 * D_HY), HY_FILTER_SCALE * HY_FFN ** -0.5),
        'hy_freq': gain((DEPTH, HY_FFN)),
        'hy_bias': nrm((DEPTH, HY_ORDER, D_HY), 0.1),
        'sg_ln_g': gain((DEPTH, SG_GROUPS, SG_GROUP_DIM)),
        'sg_ln_b': nrm((DEPTH, SG_GROUPS, SG_GROUP_DIM), 0.02),
        'sg_w': nrm((DEPTH, SG_GROUPS, SG_CHUNK, SG_CHUNK), SG_CHUNK ** -0.5),
        'sg_b': gain((DEPTH, SG_GROUPS, SG_CHUNK)),
        'q_norm_g': gain((DEPTH, QK_DIM)),
        'k_norm_g': gain((DEPTH, QK_DIM)),
        'lam_q1': nrm((DEPTH, QK_DIM), 0.1),
        'lam_k1': nrm((DEPTH, QK_DIM), 0.1),
        'lam_q2': nrm((DEPTH, QK_DIM), 0.1),
        'lam_k2': nrm((DEPTH, QK_DIM), 0.1),
        'subln_g': gain((DEPTH, V_DIM)),
        'w_out': nrm((DEPTH, D_MIX, D_MODEL), D_MIX ** -0.5),
        'norm2_g': gain((DEPTH, D_MODEL)),
        'ffn_w_up': nrm((DEPTH, D_MODEL, 2 * D_FF), D_MODEL ** -0.5),
        'ffn_conv_w': nrm((DEPTH, 3, 2 * D_FF), 3 ** -0.5),
        'ffn_conv_b': nrm((DEPTH, 2 * D_FF), 0.02),
        'ffn_w_down': nrm((DEPTH, D_FF, D_MODEL), D_FF ** -0.5),
    }


def reference(x, c, ctx, c_ctx, w_mod, b_mod, norm1_g, w_in, hy_conv_w, hy_conv_b, hy_w1, hy_b1,
              hy_w2, hy_b2, hy_w3, hy_freq, hy_bias, sg_ln_g, sg_ln_b, sg_w, sg_b, q_norm_g, k_norm_g,
              lam_q1, lam_k1, lam_q2, lam_k2, subln_g, w_out, norm2_g, ffn_w_up, ffn_conv_w,
              ffn_conv_b, ffn_w_down):
    f32 = jnp.float32
    xs, cs = x, ctx
    L = xs.shape[1]
    Lc = cs.shape[1]
    rope_cos, rope_sin = axial_rope_tables(L)
    for l in range(DEPTH):
        last = l == DEPTH - 1
        lam_init = 0.8 - 0.6 * math.exp(-0.3 * l)
        lam = (jnp.exp(jnp.sum(lam_q1[l].astype(f32) * lam_k1[l].astype(f32)))
               - jnp.exp(jnp.sum(lam_q2[l].astype(f32) * lam_k2[l].astype(f32))) + lam_init)
        m = (jax.nn.silu(c) @ w_mod[l] + b_mod[l])[:, None, :]
        sh1, sc1, g1, sh2, sc2, g2 = jnp.split(m, 6, axis=-1)
        mc = jax.nn.silu(c_ctx) @ w_mod[l] + b_mod[l]
        csh1, csc1, cg1, csh2, csc2, cg2 = jnp.split(mc, 6, axis=-1)

        h = modulate(rmsnorm(xs, norm1_g[l]), sh1, sc1)
        pa, pb, pc = jnp.split(h @ w_in[l], [IN_A, IN_A + IN_B], axis=-1)
        hc = modulate(rmsnorm(cs, norm1_g[l]), csh1, csc1)
        if last:
            pc_c = hc @ w_in[l][:, IN_A + IN_B:]
        else:
            pa_c, pb_c, pc_c = jnp.split(hc @ w_in[l], [IN_A, IN_A + IN_B], axis=-1)

        q, k, v = diff_qkv(pc, q_norm_g[l], k_norm_g[l])
        q = apply_rope(q, rope_cos, rope_sin)
        k = apply_rope(k, rope_cos, rope_sin)
        qc, kc, vc = diff_qkv(pc_c, q_norm_g[l], k_norm_g[l])
        k_all = jnp.concatenate([k, kc], axis=1)
        v_all = jnp.concatenate([v, vc], axis=1)
        o_att = diff_out(diff_attention_blocks(q, k_all, v_all, lam), subln_g[l], lam_init)

        kf = hyena_filters(L, hy_w1[l], hy_b1[l], hy_w2[l], hy_b2[l], hy_w3[l], hy_freq[l])
        o_hy = hyena_mixer(pa, hy_conv_w[l], hy_conv_b[l], kf, hy_bias[l])
        o_sg = sgu_mixer(pb, sg_ln_g[l], sg_ln_b[l], sg_w[l], sg_b[l])

        mix = jnp.concatenate([o_hy, o_sg, o_att], axis=-1) @ w_out[l]
        new_xs = xs + g1 * mix

        if not last:
            oc_att = diff_out(diff_attend(qc, kc, vc, lam), subln_g[l], lam_init)
            kf_c = hyena_filters(Lc, hy_w1[l], hy_b1[l], hy_w2[l], hy_b2[l], hy_w3[l], hy_freq[l])
            oc_hy = hyena_mixer(pa_c, hy_conv_w[l], hy_conv_b[l], kf_c, hy_bias[l])
            oc_sg = sgu_mixer(pb_c, sg_ln_g[l], sg_ln_b[l], sg_w[l], sg_b[l])
            mix_c = jnp.concatenate([oc_hy, oc_sg, oc_att], axis=-1) @ w_out[l]
            new_cs = cs + cg1 * mix_c
            hc2 = modulate(rmsnorm(new_cs, norm2_g[l]), csh2, csc2)
            cs = new_cs + cg2 * conv_ffn(hc2, ffn_w_up[l], ffn_conv_w[l], ffn_conv_b[l], ffn_w_down[l])

        h2 = modulate(rmsnorm(new_xs, norm2_g[l]), sh2, sc2)
        xs = new_xs + g2 * conv_ffn(h2, ffn_w_up[l], ffn_conv_w[l], ffn_conv_b[l], ffn_w_down[l])
    return xs
```

```cpp
#include <hip/hip_runtime.h>
#include <hip/hip_bf16.h>
#include <cstdint>
#include <cstdio>

namespace {
constexpr int DM = 1024, NB = 8, SEQ = 2048, DEPTH = 2, CTXL = 256;
constexpr int MLAT = NB * SEQ, MCTX = NB * CTXL, MTOT = MLAT + MCTX;
constexpr int D_HY = 256, D_SG = 256, NH = 4, QKD = 64, VD = 128;
constexpr int IN_A = 768, IN_B = 512, D_IN = 2816;
constexpr int COL_Q = 1280, COL_K = 1792, COL_V = 2304;
constexpr int D_FF = 2816, D_FF2 = 5632;
constexpr int HY_EMB = 33, HY_FFN = 64;
constexpr float EPS = 1e-6f;
constexpr float LOG2E = 1.4426950408889634f;
constexpr float QSCALE = 0.125f * LOG2E;
constexpr int FL = 2 * SEQ, FLC = 2 * CTXL;

constexpr size_t MiB = 1u << 20;
constexpr size_t WS_CTL = 0, CTL_BYTES = 1 * MiB;
constexpr size_t WS_MOD = 64 * 1024;
constexpr size_t WS_WIN = 1 * MiB, WS_WOUT = 12 * MiB, WS_WUP = 16 * MiB, WS_WDN = 38 * MiB;
constexpr size_t WS_CS = 49 * MiB;
constexpr size_t WS_FILT = 57 * MiB;
constexpr size_t WS_FILTC = 65 * MiB;
constexpr size_t WS_ROPE = 65 * MiB + 512 * 1024;
constexpr size_t WS_A = 66 * MiB;
constexpr size_t WS_B = 165 * MiB;
constexpr size_t WS_HBF = WS_B;
constexpr size_t WS_HYT = WS_B;
constexpr size_t HYT_LAT_ELEMS = (size_t)D_HY * NB * SEQ, HYT_CTX_ELEMS = (size_t)D_HY * NB * CTXL;
constexpr size_t WS_HYTC = WS_HYT + 4 * HYT_LAT_ELEMS * 2;
constexpr size_t WS_MIX = WS_B + 36 * MiB;
constexpr size_t WS_UCH = WS_B + 36 * MiB;
constexpr size_t WS_END = 237 * MiB;

typedef unsigned short bf16_t;
typedef float f32x4 __attribute__((ext_vector_type(4)));
typedef short bf16x8 __attribute__((ext_vector_type(8)));
typedef unsigned u32x4 __attribute__((ext_vector_type(4)));

__device__ __forceinline__ unsigned f2bf(float f) { unsigned u = __builtin_bit_cast(unsigned, f); return (u + 0x7fffu + ((u >> 16) & 1u)) >> 16; }
__device__ __forceinline__ unsigned pk2(float lo, float hi) { return f2bf(lo) | (f2bf(hi) << 16); }
__device__ __forceinline__ float bf2f(unsigned short h) { return __builtin_bit_cast(float, (unsigned)h << 16); }
__device__ __forceinline__ float bflo(unsigned w) { return __builtin_bit_cast(float, w << 16); }
__device__ __forceinline__ float bfhi(unsigned w) { return __builtin_bit_cast(float, w & 0xffff0000u); }
__device__ __forceinline__ float silu_f(float x) { return x / (1.f + __expf(-x)); }
__device__ __forceinline__ float gelu_tanh(float x) { const float u = 0.7978845608028654f * (x + 0.044715f * x * x * x); return 0.5f * x * (1.f + tanhf(u)); }

struct Params {
    const float* in[34];
    float* out;
    unsigned char* ws;
};

__device__ __forceinline__ float modv(const Params& p, int l, int r, int idx) {
    const float* acc = (const float*)(p.ws + WS_MOD);
    return acc[((size_t)l * 9 + r) * 6144 + idx];
}

__device__ __forceinline__ void transpose_item(const float* W, int K, int N, bf16_t* WT, bool upperm, float* scr, int item, int lane) {
    const int nblk = N / 32, kb = item / nblk, nb = item % nblk, k0 = 64 * kb, n0 = 32 * nb;
    int r0 = n0;
    if (upperm) { r0 = (n0 < D_FF) ? (256 * (n0 / 128) + (n0 % 128)) : (256 * ((n0 - D_FF) / 128) + 128 + ((n0 - D_FF) % 128)); }
#pragma unroll 8
    for (int i = 0; i < 32; ++i) { const int kk = 2 * i + (lane >> 5); scr[kk * 33 + (lane & 31)] = W[(size_t)(k0 + kk) * N + n0 + (lane & 31)]; }
    __builtin_amdgcn_s_waitcnt(0xc07f); asm volatile("" ::: "memory");
    const int c = lane & 7;
#pragma unroll
    for (int j = 0; j < 4; ++j) { const int n = (lane >> 3) + 8 * j; const float* s = scr + (8 * c) * 33 + n;
        u32x4 o; o.x = pk2(s[0 * 33], s[1 * 33]); o.y = pk2(s[2 * 33], s[3 * 33]); o.z = pk2(s[4 * 33], s[5 * 33]); o.w = pk2(s[6 * 33], s[7 * 33]);
        *(u32x4*)(WT + (size_t)(r0 + n) * K + k0 + 8 * c) = o; }
    __builtin_amdgcn_s_waitcnt(0xc07f); asm volatile("" ::: "memory");
}

__global__ void __launch_bounds__(256) k_wconv(Params p) {
    __shared__ float scr_all[4 * 64 * 33];
    const int lane = threadIdx.x & 63, wave = threadIdx.x >> 6;
    float* scr = scr_all + wave * 64 * 33;
    const int gw = blockIdx.x * 4 + wave, NGW = gridDim.x * 4;
    constexpr int I_IN = (DM / 64) * (D_IN / 32), I_OUT = (DM / 64) * (DM / 32), I_UP = (DM / 64) * (D_FF2 / 32), I_DN = (D_FF / 64) * (DM / 32);
    constexpr int PER_L = I_IN + I_OUT + I_UP + I_DN;
    for (int it = gw; it < DEPTH * PER_L; it += NGW) {
        const int l = it / PER_L; int r = it % PER_L;
        if (r < I_IN) { transpose_item(p.in[7] + (size_t)l * DM * D_IN, DM, D_IN, (bf16_t*)(p.ws + WS_WIN) + (size_t)l * D_IN * DM, false, scr, r, lane); continue; } r -= I_IN;
        if (r < I_OUT) { transpose_item(p.in[28] + (size_t)l * DM * DM, DM, DM, (bf16_t*)(p.ws + WS_WOUT) + (size_t)l * DM * DM, false, scr, r, lane); continue; } r -= I_OUT;
        if (r < I_UP) { transpose_item(p.in[30] + (size_t)l * DM * D_FF2, DM, D_FF2, (bf16_t*)(p.ws + WS_WUP) + (size_t)l * D_FF2 * DM, true, scr, r, lane); continue; } r -= I_UP;
        transpose_item(p.in[33] + (size_t)l * D_FF * DM, D_FF, DM, (bf16_t*)(p.ws + WS_WDN) + (size_t)l * DM * D_FF, false, scr, r, lane);
    }
}

__global__ void __launch_bounds__(512) k_mod(Params p) {
    __shared__ float s[9][32];
    float* part = (float*)(p.ws + WS_A);
    for (int item = blockIdx.x; item < DEPTH * 32 * 12; item += gridDim.x) {
        const int l = item / (32 * 12), rem = item % (32 * 12), kc = rem / 12, nc = rem % 12;
        const int k0 = kc * 32, n = nc * 512 + threadIdx.x;
        __syncthreads();
        if (threadIdx.x < 9 * 32) { const int r = threadIdx.x / 32, kk = threadIdx.x % 32;
            const float v = (r < 8) ? p.in[1][(size_t)r * DM + k0 + kk] : p.in[3][k0 + kk]; s[r][kk] = silu_f(v); }
        __syncthreads();
        float acc[9];
#pragma unroll
        for (int r = 0; r < 9; ++r) acc[r] = 0.f;
        const float* W = p.in[4] + ((size_t)l * DM + k0) * 6144 + n;
#pragma unroll 8
        for (int kk = 0; kk < 32; ++kk) { const float w = W[(size_t)kk * 6144];
#pragma unroll
            for (int r = 0; r < 9; ++r) acc[r] += s[r][kk] * w; }
#pragma unroll
        for (int r = 0; r < 9; ++r) part[(((size_t)l * 32 + kc) * 9 + r) * 6144 + n] = acc[r];
    }
}
__global__ void __launch_bounds__(256) k_modred(Params p) {
    const float* part = (const float*)(p.ws + WS_A);
    float* mod = (float*)(p.ws + WS_MOD);
    for (int e = blockIdx.x * 256 + threadIdx.x; e < DEPTH * 9 * 6144; e += gridDim.x * 256) {
        const int l = e / (9 * 6144), rn = e % (9 * 6144);
        float a = p.in[5][(size_t)l * 6144 + rn % 6144];
        for (int kc = 0; kc < 32; ++kc) a += part[((size_t)l * 32 + kc) * 9 * 6144 + rn];
        mod[e] = a;
    }
}

__global__ void __launch_bounds__(512) k_filters(Params p) {
    __shared__ float z[16][HY_EMB + 1];
    __shared__ float h1[16][HY_FFN];
    __shared__ float h2[16][HY_FFN];
    const int tid = threadIdx.x;
    constexpr int NI_L = SEQ / 16, NI_C = CTXL / 16;
    constexpr int NITEMS = DEPTH * NI_L + NI_C;
    for (int item = blockIdx.x; item < NITEMS; item += gridDim.x) {
        int l, L, pb; bf16_t* R;
        if (item < DEPTH * NI_L) { l = item / NI_L; L = SEQ; pb = item % NI_L; R = (bf16_t*)(p.ws + WS_FILT) + (size_t)l * 2 * D_HY * FL; }
        else { l = 0; L = CTXL; pb = item - DEPTH * NI_L; R = (bf16_t*)(p.ws + WS_FILTC); }
        const int FLEN = 2 * L;
        const float* w1 = p.in[10] + (size_t)l * HY_EMB * HY_FFN; const float* b1 = p.in[11] + (size_t)l * HY_FFN;
        const float* w2 = p.in[12] + (size_t)l * HY_FFN * HY_FFN; const float* b2 = p.in[13] + (size_t)l * HY_FFN;
        const float* w3 = p.in[14] + (size_t)l * HY_FFN * 1024; const float* fr = p.in[15] + (size_t)l * HY_FFN;
        __syncthreads();
        for (int e = tid; e < 16 * HY_EMB; e += 512) { const int pp = e / HY_EMB, f = e % HY_EMB; const int pos = pb * 16 + pp;
            float v;
            if (f == 0) v = (float)pos / (float)(L - 1);
            else { const int k = (f - 1) & 15; const float band = 1e-4f + (float)k * ((15.f - 1e-4f) / 15.f);
                   const float w = 6.283185307179586f * (float)pos / (float)L; const float a = band * w;
                   v = (f <= 16) ? cosf(a) : -sinf(a); }
            z[pp][f] = v; }
        __syncthreads();
        for (int e = tid; e < 16 * HY_FFN; e += 512) { const int pp = e / HY_FFN, j = e % HY_FFN; float a = b1[j];
            for (int i = 0; i < HY_EMB; ++i) a += z[pp][i] * w1[i * HY_FFN + j];
            h1[pp][j] = sinf(fr[j] * a); }
        __syncthreads();
        for (int e = tid; e < 16 * HY_FFN; e += 512) { const int pp = e / HY_FFN, j = e % HY_FFN; float a = b2[j];
            for (int i = 0; i < HY_FFN; ++i) a += h1[pp][i] * w2[i * HY_FFN + j];
            h2[pp][j] = sinf(fr[j] * a); }
        __syncthreads();
        for (int o = tid; o < 1024; o += 512) {
            float acc[16];
#pragma unroll
            for (int pp = 0; pp < 16; ++pp) acc[pp] = 0.f;
            for (int k = 0; k < HY_FFN; ++k) { const float w = w3[k * 1024 + o];
#pragma unroll
                for (int pp = 0; pp < 16; ++pp) acc[pp] += h2[pp][k] * w; }
            const int order = o >> 9, dir = (o >> 8) & 1, c = o & 255;
            const float mind = -4.605170185988091f / 1.5f, maxd = -4.605170185988091f / 0.3f;
            const float delta = fabsf(mind + (float)c * ((maxd - mind) / 255.f));
            bf16_t* Rc = R + ((size_t)order * D_HY + c) * FLEN;
#pragma unroll
            for (int pp = 0; pp < 16; ++pp) { const int pos = pb * 16 + pp; const float t = (float)pos / (float)(L - 1);
                const float v = acc[pp] * __expf(-t * delta);
                if (dir == 0) Rc[L - 1 - pos] = (bf16_t)f2bf(v);
                else if (pos > 0) Rc[L - 1 + pos] = (bf16_t)f2bf(v); }
            if (pb == 0 && dir == 0) Rc[FLEN - 1] = 0;
        }
    }
}

__global__ void __launch_bounds__(256) k_rope(Params p) {
    float* tab = (float*)(p.ws + WS_ROPE);
    for (int e = blockIdx.x * 256 + threadIdx.x; e < SEQ * 32; e += gridDim.x * 256) {
        const int pos = e >> 5, axis = (e >> 4) & 1, pr = e & 15;
        const float inv = exp2f(-(float)pr * (13.287712379549449f / 16.f));
        const float coord = axis == 0 ? (float)(pos / 64) : (float)(pos % 64);
        const float a = coord * inv;
        tab[2 * e] = cosf(a); tab[2 * e + 1] = sinf(a);
    }
}

__global__ void __launch_bounds__(512) k_norm(Params p, int l, int which, int nrows) {
    const int lane = threadIdx.x & 63, gw = blockIdx.x * 8 + (threadIdx.x >> 6), NGW = gridDim.x * 8;
    const float* g = (which == 0 ? p.in[6] : p.in[29]) + (size_t)l * DM;
    const int osh = which == 0 ? 0 : 3072, osc = which == 0 ? 1024 : 4096;
    bf16_t* H = (bf16_t*)(p.ws + WS_HBF);
    for (int row = gw; row < nrows; row += NGW) {
        const float* src; int mr;
        if (row < MLAT) { mr = row / SEQ; src = ((l == 0 && which == 0) ? p.in[0] : p.out) + (size_t)row * DM; }
        else { mr = 8; src = ((l == 0 && which == 0) ? p.in[2] : (const float*)(p.ws + WS_CS)) + (size_t)(row - MLAT) * DM; }
        f32x4 v[4]; float ss = 0.f;
#pragma unroll
        for (int j = 0; j < 4; ++j) { v[j] = *(const f32x4*)(src + 4 * lane + 256 * j); ss += (v[j].x * v[j].x + v[j].y * v[j].y) + (v[j].z * v[j].z + v[j].w * v[j].w); }
#pragma unroll
        for (int o = 1; o < 64; o <<= 1) ss += __shfl_xor(ss, o);
        const float rstd = rsqrtf(ss * (1.f / DM) + EPS);
#pragma unroll
        for (int j = 0; j < 4; ++j) { const int col = 4 * lane + 256 * j; float o4[4];
#pragma unroll
            for (int e = 0; e < 4; ++e) { const float y = v[j][e] * rstd * g[col + e]; o4[e] = y * (1.f + modv(p, l, mr, osc + col + e)) + modv(p, l, mr, osh + col + e); }
            uint2 w; w.x = pk2(o4[0], o4[1]); w.y = pk2(o4[2], o4[3]);
            *(uint2*)(H + (size_t)row * DM + col) = w; }
    }
}

template <class Epi>
__global__ void __launch_bounds__(256) k_gemm_naive(const bf16_t* A, const bf16_t* Bt, int K, int row0, Epi E) {
    __shared__ __attribute__((aligned(16))) bf16_t sA[64][40];
    __shared__ __attribute__((aligned(16))) bf16_t sB[64][40];
    const int tid = threadIdx.x, lane = tid & 63, w = tid >> 6, lr = lane & 15, quad = lane >> 4;
    const int m0 = row0 + blockIdx.y * 64, n0 = blockIdx.x * 64;
    f32x4 acc[4];
#pragma unroll
    for (int i = 0; i < 4; ++i) acc[i] = (f32x4){0.f, 0.f, 0.f, 0.f};
    const int sr = tid >> 2, sk = (tid & 3) * 8;
    for (int k0 = 0; k0 < K; k0 += 32) {
        const u32x4 va = *(const u32x4*)(A + (size_t)(m0 + sr) * K + k0 + sk);
        const u32x4 vb = *(const u32x4*)(Bt + (size_t)(n0 + sr) * K + k0 + sk);
        __syncthreads();
        *(u32x4*)&sA[sr][sk] = va; *(u32x4*)&sB[sr][sk] = vb;
        __syncthreads();
        const bf16x8 a = *(const bf16x8*)&sA[16 * w + lr][quad * 8];
#pragma unroll
        for (int nt = 0; nt < 4; ++nt) { const bf16x8 b = *(const bf16x8*)&sB[16 * nt + lr][quad * 8];
            acc[nt] = __builtin_amdgcn_mfma_f32_16x16x32_bf16(a, b, acc[nt], 0, 0, 0); }
    }
#pragma unroll
    for (int nt = 0; nt < 4; ++nt)
#pragma unroll
        for (int j = 0; j < 4; ++j) E(m0 + 16 * w + quad * 4 + j, n0 + 16 * nt + lr, acc[nt][j]);
}
struct EpiStoreBf16 { bf16_t* O; int ldc; int rowoff;
    __device__ __forceinline__ void operator()(int row, int col, float v) const { O[(size_t)(row - rowoff) * ldc + col] = (bf16_t)f2bf(v); } };
struct EpiResid { Params p; int l; int gidx; const float* base_lat; const float* base_ctx;
    __device__ __forceinline__ void operator()(int row, int col, float v) const {
        if (row < MLAT) { const float g = modv(p, l, row / SEQ, gidx + col); p.out[(size_t)row * DM + col] = base_lat[(size_t)row * DM + col] + g * v; }
        else { const float g = modv(p, l, 8, gidx + col); float* cs = (float*)(p.ws + WS_CS); const size_t o = (size_t)(row - MLAT) * DM + col; cs[o] = base_ctx[o] + g * v; } } };

__global__ void __launch_bounds__(512) k_prep_qk(Params p, int l, int nrows) {
    const int lane = threadIdx.x & 63, gw = blockIdx.x * 8 + (threadIdx.x >> 6), NGW = gridDim.x * 8;
    bf16_t* P = (bf16_t*)(p.ws + WS_A);
    const float* tab = (const float*)(p.ws + WS_ROPE);
    const int v = lane >> 2, quarter = lane & 3, axis = quarter >> 1, half = quarter & 1;
    const float* gn = (v < 8 ? p.in[21] : p.in[22]) + (size_t)l * QKD + quarter * 16;
    float g[16];
#pragma unroll
    for (int i = 0; i < 16; ++i) g[i] = gn[i];
    for (int row = gw; row < nrows; row += NGW) {
        bf16_t* ptr = P + (size_t)row * D_IN + COL_Q + v * 64 + quarter * 16;
        const u32x4 w0 = *(const u32x4*)ptr, w1 = *(const u32x4*)(ptr + 8);
        float x[16];
        x[0] = bflo(w0.x); x[1] = bfhi(w0.x); x[2] = bflo(w0.y); x[3] = bfhi(w0.y); x[4] = bflo(w0.z); x[5] = bfhi(w0.z); x[6] = bflo(w0.w); x[7] = bfhi(w0.w);
        x[8] = bflo(w1.x); x[9] = bfhi(w1.x); x[10] = bflo(w1.y); x[11] = bfhi(w1.y); x[12] = bflo(w1.z); x[13] = bfhi(w1.z); x[14] = bflo(w1.w); x[15] = bfhi(w1.w);
        float ss = 0.f;
#pragma unroll
        for (int i = 0; i < 16; ++i) ss += x[i] * x[i];
        ss += __shfl_xor(ss, 1); ss += __shfl_xor(ss, 2);
        const float rstd = rsqrtf(ss * (1.f / QKD) + EPS);
        float y[16];
#pragma unroll
        for (int i = 0; i < 16; ++i) y[i] = x[i] * rstd * g[i];
        if (row < MLAT) {
            const int pos = row % SEQ;
            const float* tp = tab + ((size_t)pos * 2 + axis) * 32;
#pragma unroll
            for (int i = 0; i < 16; ++i) { const float other = __shfl_xor(y[i], 1); const float c = tp[2 * i], s = tp[2 * i + 1];
                y[i] = half == 0 ? (y[i] * c - other * s) : (y[i] * c + other * s); }
        }
        const float sc = v < 8 ? QSCALE : 1.f;
        u32x4 o0, o1;
        o0.x = pk2(y[0] * sc, y[1] * sc); o0.y = pk2(y[2] * sc, y[3] * sc); o0.z = pk2(y[4] * sc, y[5] * sc); o0.w = pk2(y[6] * sc, y[7] * sc);
        o1.x = pk2(y[8] * sc, y[9] * sc); o1.y = pk2(y[10] * sc, y[11] * sc); o1.z = pk2(y[12] * sc, y[13] * sc); o1.w = pk2(y[14] * sc, y[15] * sc);
        *(u32x4*)ptr = o0; *(u32x4*)(ptr + 8) = o1;
    }
}

constexpr int HYP_LD = 66;
__global__ void __launch_bounds__(512) k_prep_hy(Params p, int l, int nitems) {
    extern __shared__ __attribute__((aligned(16))) unsigned char smem[];
    bf16_t* T = (bf16_t*)smem;
    const bf16_t* P = (const bf16_t*)(p.ws + WS_A);
    const float* cw = p.in[8] + (size_t)l * 3 * IN_A; const float* cb = p.in[9] + (size_t)l * IN_A;
    const int tid = threadIdx.x;
    for (int item = blockIdx.x; item < nitems; item += gridDim.x) {
        int b, t0, L; size_t rowbase; bf16_t* dst; size_t which_stride;
        if (item < 256) { b = item >> 5; t0 = (item & 31) * 64; L = SEQ; rowbase = (size_t)b * SEQ; dst = (bf16_t*)(p.ws + WS_HYT); which_stride = HYT_LAT_ELEMS; }
        else { const int it = item - 256; b = it >> 2; t0 = (it & 3) * 64; L = CTXL; rowbase = (size_t)MLAT + (size_t)b * CTXL; dst = (bf16_t*)(p.ws + WS_HYTC); which_stride = HYT_CTX_ELEMS; }
        __syncthreads();
        for (int idx = tid; idx < 64 * 384; idx += 512) {
            const int tl = idx / 384, c = (idx % 384) * 2, t = t0 + tl;
            const bf16_t* pr = P + (rowbase + t) * D_IN + c;
            const unsigned cur = *(const unsigned*)pr;
            const unsigned prv = t > 0 ? *(const unsigned*)(pr - D_IN) : 0u;
            const unsigned nxt = t < L - 1 ? *(const unsigned*)(pr + D_IN) : 0u;
            const float v0 = cw[c] * bflo(prv) + cw[IN_A + c] * bflo(cur) + cw[2 * IN_A + c] * bflo(nxt) + cb[c];
            const float v1 = cw[c + 1] * bfhi(prv) + cw[IN_A + c + 1] * bfhi(cur) + cw[2 * IN_A + c + 1] * bfhi(nxt) + cb[c + 1];
            T[c * HYP_LD + tl] = (bf16_t)f2bf(v0); T[(c + 1) * HYP_LD + tl] = (bf16_t)f2bf(v1);
        }
        __syncthreads();
        for (int ch = tid; ch < 768 * 8; ch += 512) {
            const int c = ch >> 3, part = ch & 7;
            const unsigned* s = (const unsigned*)(T + c * HYP_LD + part * 8);
            u32x4 o; o.x = s[0]; o.y = s[1]; o.z = s[2]; o.w = s[3];
            bf16_t* d = dst + (size_t)(c >> 8) * which_stride + ((size_t)(c & 255) * NB + b) * L + t0 + part * 8;
            *(u32x4*)d = o;
        }
    }
}

__global__ void __launch_bounds__(512) k_sgu(Params p, int l, int nitems) {
    extern __shared__ __attribute__((aligned(16))) unsigned char smem[];
    float* Wl = (float*)smem;
    float* Vl = Wl + 128 * 129;
    const bf16_t* P = (const bf16_t*)(p.ws + WS_A);
    bf16_t* MIX = (bf16_t*)(p.ws + WS_MIX);
    const int tid = threadIdx.x;
    for (int item = blockIdx.x; item < nitems; item += gridDim.x) {
        int g; size_t row0;
        if (item < 512) { g = item & 3; const int bc = item >> 2; row0 = (size_t)bc * 128; }
        else { const int it = item - 512; g = it & 3; row0 = (size_t)MLAT + (size_t)(it >> 2) * 128; }
        const float* Wg = p.in[19] + ((size_t)l * 4 + g) * 128 * 128;
        __syncthreads();
        for (int e = tid; e < 128 * 128; e += 512) Wl[(e >> 7) * 129 + (e & 127)] = Wg[e];
        {
            const int q = tid >> 2, dq = tid & 3;
            const bf16_t* src = P + (row0 + q) * D_IN + IN_A + D_SG + g * 64 + dq * 16;
            const u32x4 w0 = *(const u32x4*)src, w1 = *(const u32x4*)(src + 8);
            float x[16];
            x[0] = bflo(w0.x); x[1] = bfhi(w0.x); x[2] = bflo(w0.y); x[3] = bfhi(w0.y); x[4] = bflo(w0.z); x[5] = bfhi(w0.z); x[6] = bflo(w0.w); x[7] = bfhi(w0.w);
            x[8] = bflo(w1.x); x[9] = bfhi(w1.x); x[10] = bflo(w1.y); x[11] = bfhi(w1.y); x[12] = bflo(w1.z); x[13] = bfhi(w1.z); x[14] = bflo(w1.w); x[15] = bfhi(w1.w);
            float s = 0.f;
#pragma unroll
            for (int i = 0; i < 16; ++i) { x[i] = gelu_tanh(x[i]); s += x[i]; }
            s += __shfl_xor(s, 1); s += __shfl_xor(s, 2);
            const float mu = s * (1.f / 64.f); float s2 = 0.f;
#pragma unroll
            for (int i = 0; i < 16; ++i) { x[i] -= mu; s2 += x[i] * x[i]; }
            s2 += __shfl_xor(s2, 1); s2 += __shfl_xor(s2, 2);
            const float rstd = rsqrtf(s2 * (1.f / 64.f) + EPS);
            const float* lg = p.in[17] + ((size_t)l * 4 + g) * 64 + dq * 16; const float* lb = p.in[18] + ((size_t)l * 4 + g) * 64 + dq * 16;
#pragma unroll
            for (int i = 0; i < 16; ++i) Vl[q * 64 + dq * 16 + i] = x[i] * rstd * lg[i] + lb[i];
        }
        __syncthreads();
        const int pp = tid >> 2, dq = tid & 3;
        float acc[16];
#pragma unroll
        for (int i = 0; i < 16; ++i) acc[i] = 0.f;
        for (int q = 0; q < 128; ++q) { const float w = Wl[pp * 129 + q]; const float* vv = Vl + q * 64 + dq * 16;
#pragma unroll
            for (int i = 0; i < 16; ++i) acc[i] += w * vv[i]; }
        const float bs = p.in[20][((size_t)l * 4 + g) * 128 + pp];
        const bf16_t* us = P + (row0 + pp) * D_IN + IN_A + g * 64 + dq * 16;
        const u32x4 w0 = *(const u32x4*)us, w1 = *(const u32x4*)(us + 8);
        float u[16];
        u[0] = bflo(w0.x); u[1] = bfhi(w0.x); u[2] = bflo(w0.y); u[3] = bfhi(w0.y); u[4] = bflo(w0.z); u[5] = bfhi(w0.z); u[6] = bflo(w0.w); u[7] = bfhi(w0.w);
        u[8] = bflo(w1.x); u[9] = bfhi(w1.x); u[10] = bflo(w1.y); u[11] = bfhi(w1.y); u[12] = bflo(w1.z); u[13] = bfhi(w1.z); u[14] = bflo(w1.w); u[15] = bfhi(w1.w);
        float o[16];
#pragma unroll
        for (int i = 0; i < 16; ++i) o[i] = gelu_tanh(u[i]) * (acc[i] + bs);
        u32x4 o0, o1;
        o0.x = pk2(o[0], o[1]); o0.y = pk2(o[2], o[3]); o0.z = pk2(o[4], o[5]); o0.w = pk2(o[6], o[7]);
        o1.x = pk2(o[8], o[9]); o1.y = pk2(o[10], o[11]); o1.z = pk2(o[12], o[13]); o1.w = pk2(o[14], o[15]);
        bf16_t* d = MIX + (row0 + pp) * DM + D_HY + g * 64 + dq * 16;
        *(u32x4*)d = o0; *(u32x4*)(d + 8) = o1;
    }
}

__device__ __forceinline__ float lam_of(const Params& p, int l, float& lam_init) {
    lam_init = 0.8f - 0.6f * expf(-0.3f * (float)l);
    float s1 = 0.f, s2 = 0.f;
    for (int i = 0; i < QKD; ++i) { s1 += p.in[23][l * QKD + i] * p.in[24][l * QKD + i]; s2 += p.in[25][l * QKD + i] * p.in[26][l * QKD + i]; }
    return expf(s1) - expf(s2) + lam_init;
}
__device__ __forceinline__ float score_shift(const Params& p, int l) {
    float gq = 0.f, gk = 0.f;
    for (int i = 0; i < QKD; ++i) { gq = fmaxf(gq, fabsf(p.in[21][l * QKD + i])); gk = fmaxf(gk, fabsf(p.in[22][l * QKD + i])); }
    return 8.f * gq * gk * LOG2E;
}
__global__ void __launch_bounds__(256) k_att_naive(Params p, int l, int ctx_mode) {
    __shared__ float Ks[32][128];
    __shared__ float Vs[32][128];
    __shared__ float red[64][4];
    const bf16_t* P = (const bf16_t*)(p.ws + WS_A);
    bf16_t* MIX = (bf16_t*)(p.ws + WS_MIX);
    const int tid = threadIdx.x, qr = tid & 63, vq = tid >> 6;
    int b, h, q0; size_t qrowbase; int nk;
    if (!ctx_mode) { const int blk = blockIdx.x; b = blk >> 7; h = (blk >> 5) & 3; q0 = (blk & 31) * 64; qrowbase = (size_t)b * SEQ; nk = SEQ + CTXL; }
    else { const int blk = blockIdx.x; b = blk >> 4; h = (blk >> 2) & 3; q0 = (blk & 3) * 64; qrowbase = (size_t)MLAT + (size_t)b * CTXL; nk = CTXL; }
    float lam_init; const float lam = lam_of(p, l, lam_init); const float M2 = score_shift(p, l);
    float q1[64], q2[64];
    { const bf16_t* qp = P + (qrowbase + q0 + qr) * D_IN + COL_Q + h * 128;
#pragma unroll
      for (int i = 0; i < 64; ++i) { q1[i] = bf2f(qp[i]); q2[i] = bf2f(qp[64 + i]); } }
    float o1[32], o2[32], l1 = 0.f, l2 = 0.f;
#pragma unroll
    for (int i = 0; i < 32; ++i) { o1[i] = 0.f; o2[i] = 0.f; }
    for (int k0 = 0; k0 < nk; k0 += 32) {
        __syncthreads();
        for (int e = tid; e < 32 * 128; e += 256) { const int j = e >> 7, d = e & 127; const int key = k0 + j;
            size_t krow;
            if (ctx_mode) krow = (size_t)MLAT + (size_t)b * CTXL + key;
            else krow = key < SEQ ? (size_t)b * SEQ + key : (size_t)MLAT + (size_t)b * CTXL + (key - SEQ);
            Ks[j][d] = bf2f(P[krow * D_IN + COL_K + h * 128 + d]); Vs[j][d] = bf2f(P[krow * D_IN + COL_V + h * 128 + d]); }
        __syncthreads();
        for (int j = 0; j < 32; ++j) {
            float s1 = 0.f, s2 = 0.f;
#pragma unroll
            for (int d = 0; d < 64; ++d) { s1 += q1[d] * Ks[j][d]; s2 += q2[d] * Ks[j][64 + d]; }
            const float p1 = exp2f(s1 - M2), p2 = exp2f(s2 - M2);
            l1 += p1; l2 += p2;
#pragma unroll
            for (int e = 0; e < 32; ++e) { const float v = Vs[j][32 * vq + e]; o1[e] += p1 * v; o2[e] += p2 * v; }
        }
    }
    const float r1 = 1.f / l1, r2 = lam / l2; float ss = 0.f;
#pragma unroll
    for (int e = 0; e < 32; ++e) { o1[e] = o1[e] * r1 - o2[e] * r2; ss += o1[e] * o1[e]; }
    red[qr][vq] = ss;
    __syncthreads();
    const float tot = red[qr][0] + red[qr][1] + red[qr][2] + red[qr][3];
    const float rstd = rsqrtf(tot * (1.f / VD) + EPS) * (1.f - lam_init);
    bf16_t* d = MIX + (qrowbase + q0 + qr) * DM + 512 + h * 128 + 32 * vq;
#pragma unroll
    for (int e = 0; e < 32; ++e) d[e] = (bf16_t)f2bf(o1[e] * rstd * p.in[27][l * VD + 32 * vq + e]);
}

__global__ void __launch_bounds__(256) k_hyconv_naive(Params p, int l, int order, int ctx_mode) {
    __shared__ float Rs[FL];
    __shared__ float Us[SEQ];
    const int c = blockIdx.x >> 3, b = blockIdx.x & 7, tid = threadIdx.x;
    const int L = ctx_mode ? CTXL : SEQ, FLEN = 2 * L;
    const bf16_t* R = ctx_mode ? (const bf16_t*)(p.ws + WS_FILTC) + ((size_t)order * D_HY + c) * FLEN
                               : (const bf16_t*)(p.ws + WS_FILT) + (((size_t)l * 2 + order) * D_HY + c) * FLEN;
    const bf16_t* HY = ctx_mode ? (const bf16_t*)(p.ws + WS_HYTC) : (const bf16_t*)(p.ws + WS_HYT);
    const size_t wst = ctx_mode ? HYT_CTX_ELEMS : HYT_LAT_ELEMS;
    const size_t off = ((size_t)c * NB + b) * L;
    const bf16_t* Uin = HY + (order == 0 ? 0 : 3) * wst + off;
    const bf16_t* Xg = HY + (order == 0 ? 1 : 2) * wst + off;
    for (int i = tid; i < FLEN; i += 256) Rs[i] = bf2f(R[i]);
    for (int i = tid; i < L; i += 256) Us[i] = bf2f(Uin[i]);
    __syncthreads();
    const float bias = p.in[16][((size_t)l * 2 + order) * D_HY + c];
    for (int t = tid; t < L; t += 256) {
        float y = 0.f; const float* rr = Rs + (L - 1 - t);
        for (int s = 0; s < L; ++s) y += rr[s] * Us[s];
        const float v = bf2f(Xg[t]) * (y + bias * Us[t]);
        if (order == 0) ((bf16_t*)HY)[3 * wst + off + t] = (bf16_t)f2bf(v);
        else { const size_t row = ctx_mode ? (size_t)MLAT + (size_t)b * CTXL + t : (size_t)b * SEQ + t;
               ((bf16_t*)(p.ws + WS_MIX))[row * DM + c] = (bf16_t)f2bf(v); }
    }
}

__global__ void __launch_bounds__(256) k_convgate(Params p, int l, int row0, int nrows, int L) {
    const bf16_t* U = (const bf16_t*)(p.ws + WS_UCH);
    bf16_t* G = (bf16_t*)(p.ws + WS_A);
    const float* cw = p.in[31] + (size_t)l * 3 * D_FF2; const float* cb = p.in[32] + (size_t)l * D_FF2;
    for (size_t e = (size_t)blockIdx.x * 256 + threadIdx.x; e < (size_t)nrows * D_FF; e += (size_t)gridDim.x * 256) {
        const int rl = (int)(e / D_FF), o = (int)(e % D_FF), t = rl % L;
        const int rg = 256 * (o / 128) + (o % 128), rv = rg + 128;
        const bf16_t* u = U + (size_t)rl * D_FF2;
        const float gp = t > 0 ? bf2f(u[rg - D_FF2]) : 0.f, gc = bf2f(u[rg]), gn = t < L - 1 ? bf2f(u[rg + D_FF2]) : 0.f;
        const float vp = t > 0 ? bf2f(u[rv - D_FF2]) : 0.f, vc = bf2f(u[rv]), vn = t < L - 1 ? bf2f(u[rv + D_FF2]) : 0.f;
        const float cg = cw[o] * gp + cw[D_FF2 + o] * gc + cw[2 * D_FF2 + o] * gn + cb[o];
        const float cv = cw[D_FF + o] * vp + cw[D_FF2 + D_FF + o] * vc + cw[2 * D_FF2 + D_FF + o] * vn + cb[D_FF + o];
        G[(size_t)(row0 + rl) * D_FF + o] = (bf16_t)f2bf(silu_f(cg) * cv);
    }
}
}

extern "C" void kernel_launch(void* const* d_in, const int* in_sizes, int n_in, void* d_out, int out_size, void* d_ws, size_t ws_size, hipStream_t stream) {
    static int ok = 0;
    if (ok == 0) {
        if (n_in != 34 || in_sizes[0] != MLAT * DM || out_size != MLAT * DM || ws_size < WS_END) {
            fprintf(stderr, "kernel_launch: unexpected shapes n_in %d in0 %d out %d ws %zu\n", n_in, n_in > 0 ? in_sizes[0] : -1, out_size, ws_size); ok = -1; return; }
        hipFuncSetAttribute((const void*)k_prep_hy, hipFuncAttributeMaxDynamicSharedMemorySize, 768 * HYP_LD * 2);
        hipFuncSetAttribute((const void*)k_sgu, hipFuncAttributeMaxDynamicSharedMemorySize, (128 * 129 + 128 * 64) * 4);
        ok = 1;
    }
    if (ok < 0) return;
    Params p{};
    for (int i = 0; i < 34; ++i) p.in[i] = (const float*)d_in[i];
    p.out = (float*)d_out; p.ws = (unsigned char*)d_ws;
    hipMemsetAsync((char*)d_ws + WS_CTL, 0, CTL_BYTES, stream);
    k_wconv<<<1024, 256, 0, stream>>>(p);
    k_mod<<<256, 512, 0, stream>>>(p);
    k_modred<<<256, 256, 0, stream>>>(p);
    k_filters<<<272, 512, 0, stream>>>(p);
    k_rope<<<256, 256, 0, stream>>>(p);
    bf16_t* HBF = (bf16_t*)(p.ws + WS_HBF); bf16_t* PA = (bf16_t*)(p.ws + WS_A); bf16_t* MIX = (bf16_t*)(p.ws + WS_MIX); bf16_t* UCH = (bf16_t*)(p.ws + WS_UCH);
    for (int l = 0; l < DEPTH; ++l) {
        const bool last = (l == DEPTH - 1);
        const bf16_t* Win = (const bf16_t*)(p.ws + WS_WIN) + (size_t)l * D_IN * DM;
        const bf16_t* Wout = (const bf16_t*)(p.ws + WS_WOUT) + (size_t)l * DM * DM;
        const bf16_t* Wup = (const bf16_t*)(p.ws + WS_WUP) + (size_t)l * D_FF2 * DM;
        const bf16_t* Wdn = (const bf16_t*)(p.ws + WS_WDN) + (size_t)l * DM * D_FF;
        k_norm<<<256, 512, 0, stream>>>(p, l, 0, MTOT);
        if (!last) k_gemm_naive<EpiStoreBf16><<<dim3(D_IN / 64, MTOT / 64), 256, 0, stream>>>(HBF, Win, DM, 0, EpiStoreBf16{PA, D_IN, 0});
        else {
            k_gemm_naive<EpiStoreBf16><<<dim3(D_IN / 64, MLAT / 64), 256, 0, stream>>>(HBF, Win, DM, 0, EpiStoreBf16{PA, D_IN, 0});
            k_gemm_naive<EpiStoreBf16><<<dim3((D_IN - COL_Q) / 64, MCTX / 64), 256, 0, stream>>>(HBF, Win + (size_t)COL_Q * DM, DM, MLAT, EpiStoreBf16{PA + COL_Q, D_IN, 0});
        }
        k_prep_qk<<<256, 512, 0, stream>>>(p, l, MTOT);
        k_prep_hy<<<288, 512, 768 * HYP_LD * 2, stream>>>(p, l, last ? 256 : 288);
        k_sgu<<<576, 512, (128 * 129 + 128 * 64) * 4, stream>>>(p, l, last ? 512 : 576);
        k_att_naive<<<NB * NH * 32, 256, 0, stream>>>(p, l, 0);
        k_hyconv_naive<<<D_HY * NB, 256, 0, stream>>>(p, l, 0, 0);
        k_hyconv_naive<<<D_HY * NB, 256, 0, stream>>>(p, l, 1, 0);
        if (!last) {
            k_att_naive<<<NB * NH * 4, 256, 0, stream>>>(p, l, 1);
            k_hyconv_naive<<<D_HY * NB, 256, 0, stream>>>(p, l, 0, 1);
            k_hyconv_naive<<<D_HY * NB, 256, 0, stream>>>(p, l, 1, 1);
        }
        const int mrows = last ? MLAT : MTOT;
        k_gemm_naive<EpiResid><<<dim3(DM / 64, mrows / 64), 256, 0, stream>>>(MIX, Wout, DM, 0,
            EpiResid{p, l, 2048, l == 0 ? p.in[0] : (const float*)p.out, l == 0 ? p.in[2] : (const float*)(p.ws + WS_CS)});
        k_norm<<<256, 512, 0, stream>>>(p, l, 1, mrows);
        const int nch = mrows / 2048;
        for (int ch = 0; ch < nch; ++ch) {
            const int r0 = ch * 2048, L = r0 < MLAT ? SEQ : CTXL;
            k_gemm_naive<EpiStoreBf16><<<dim3(D_FF2 / 64, 2048 / 64), 256, 0, stream>>>(HBF, Wup, DM, r0, EpiStoreBf16{UCH, D_FF2, r0});
            k_convgate<<<2048, 256, 0, stream>>>(p, l, r0, 2048, L);
        }
        k_gemm_naive<EpiResid><<<dim3(DM / 64, mrows / 64), 256, 0, stream>>>(PA, Wdn, D_FF, 0,
            EpiResid{p, l, 5120, (const float*)p.out, (const float*)(p.ws + WS_CS)});
    }
}
```

```cpp
#include <hip/hip_runtime.h>
#include <hip/hip_bf16.h>
#include <cstdint>
#include <cstdio>

#ifndef MK_PER_PHASE
#define MK_PER_PHASE 0
#endif
#ifndef PROBE_PH
#define PROBE_PH -1
#endif
#ifndef PROBE_REP
#define PROBE_REP 4
#endif
#ifndef PROBE_SUB
#define PROBE_SUB 0xff
#endif
namespace {
constexpr int DM = 1024, NB = 8, SEQ = 2048, DEPTH = 2, CTXL = 256;
constexpr int MLAT = NB * SEQ, MCTX = NB * CTXL, MTOT = MLAT + MCTX;
constexpr int D_HY = 256, D_SG = 256, NH = 4, QKD = 64, VD = 128;
constexpr int IN_A = 768, IN_B = 512, D_IN = 2816;
constexpr int COL_Q = 1280, COL_K = 1792, COL_V = 2304;
constexpr int D_FF = 2816, D_FF2 = 5632;
constexpr int HY_EMB = 33, HY_FFN = 64;
constexpr float EPS = 1e-6f;
constexpr float LOG2E = 1.4426950408889634f;
constexpr float QSCALE = 0.125f * LOG2E;
constexpr int FL = 2 * SEQ, FLC = 2 * CTXL;

constexpr size_t MiB = 1u << 20;
constexpr size_t WS_CTL = 0, CTL_BYTES = 2 * MiB;
constexpr size_t WS_MOD = 64 * 1024;
constexpr size_t WS_SS = 1 * MiB;
constexpr size_t WS_SHW = 2 * MiB;
constexpr size_t WS_WIN = 3 * MiB, WS_WOUT = 14 * MiB, WS_WUP = 18 * MiB, WS_WDN = 40 * MiB;
constexpr size_t WS_CS = 51 * MiB;
constexpr size_t WS_FILT = 59 * MiB;
constexpr size_t WS_FILTC = 67 * MiB;
constexpr size_t WS_ROPE = 67 * MiB + 512 * 1024;
constexpr size_t WS_A = 68 * MiB;
constexpr size_t WS_B = 167 * MiB;
constexpr size_t WS_HBF = WS_B;
constexpr size_t WS_HYT = WS_B;
constexpr size_t HYT_LAT_ELEMS = (size_t)D_HY * NB * SEQ, HYT_CTX_ELEMS = (size_t)D_HY * NB * CTXL;
constexpr size_t WS_HYTC = WS_HYT + 4 * HYT_LAT_ELEMS * 2;
constexpr size_t WS_MIX = WS_B + 36 * MiB;
constexpr size_t WS_UCH = WS_B + 36 * MiB;
constexpr size_t WS_END = 239 * MiB;
constexpr float SS_SCALE = 16777216.f, SS_INV = 1.f / (16777216.f * 1024.f);

typedef unsigned short bf16_t;
typedef float f32x4 __attribute__((ext_vector_type(4)));
typedef short bf16x8 __attribute__((ext_vector_type(8)));
typedef unsigned u32x4 __attribute__((ext_vector_type(4)));

__device__ __forceinline__ unsigned f2bf(float f) { unsigned u = __builtin_bit_cast(unsigned, f); return (u + 0x7fffu + ((u >> 16) & 1u)) >> 16; }
__device__ __forceinline__ unsigned pk2(float lo, float hi) { return f2bf(lo) | (f2bf(hi) << 16); }
__device__ __forceinline__ float bf2f(unsigned short h) { return __builtin_bit_cast(float, (unsigned)h << 16); }
__device__ __forceinline__ float bflo(unsigned w) { return __builtin_bit_cast(float, w << 16); }
__device__ __forceinline__ float bfhi(unsigned w) { return __builtin_bit_cast(float, w & 0xffff0000u); }
__device__ __forceinline__ float silu_f(float x) { return x / (1.f + __expf(-x)); }
__device__ __forceinline__ float gelu_tanh(float x) { const float u2 = 1.5957691216057308f * (x + 0.044715f * x * x * x); return x * __builtin_amdgcn_rcpf(1.f + __expf(-u2)); }

struct Params {
    const float* in[34];
    float* out;
    unsigned char* ws;
};

__device__ __forceinline__ float modv(const Params& p, int l, int r, int idx) {
    const float* acc = (const float*)(p.ws + WS_MOD);
    return acc[((size_t)l * 9 + r) * 6144 + idx];
}

constexpr int NWAVES = 8;

#define PG8_LAS __attribute__((address_space(3)))
constexpr int BM = 256, BK = 64, HALF = 128, HTB = HALF * BK * 2  , STAGE_BYTES = 8 * HTB, NXCD = 8, WGM = 8;

__host__ __device__ __forceinline__ int lds_byte(int r, int c) { const int st = (r >> 4) * 2 + (c >> 5), rr = r & 15, cc = c & 31, ob = rr * 64 + cc * 2; return st * 1024 + (ob ^ (((ob >> 9) & 1) << 5)); }
__host__ __device__ __forceinline__ void stage_rc(int b, int& R, int& C) { const int st = b / 1024, sb = b % 1024, swz = sb ^ (((sb >> 9) & 1) << 5); R = (st >> 1) * 16 + swz / 64; C = (st & 1) * 32 + (swz % 64) / 2; }
__host__ __device__ __forceinline__ int perm32(int rho) { const int n = rho >> 4, i = rho & 15; return 8 * (i >> 2) + 4 * n + (i & 3); }

struct Unit { int pm, pn; };
struct Gemm { const bf16_t* A; const bf16_t* Bt; int M, N, K; };


struct RectOrder {
    int nM1, nN1, n1, nM2, nN2, n2, pm2off, pn2off, G, c;
    __device__ void init(int nM1_, int nN1_, int nM2_, int nN2_, int pm2off_, int pn2off_, int G_, int c_) {
        nM1 = nM1_; nN1 = nN1_; n1 = nM1_ * nN1_; nM2 = nM2_; nN2 = nN2_; n2 = nM2_ * nN2_; pm2off = pm2off_; pn2off = pn2off_; G = G_; c = c_; }
    __device__ __forceinline__ static void map(int wgid, int nM, int nN, int nwg, Unit& u) {
        { const int q = nwg / NXCD, r = nwg % NXCD, xcd = wgid % NXCD, off = wgid / NXCD; wgid = (xcd < r ? xcd * (q + 1) : r * (q + 1) + (xcd - r) * q) + off; }
        const int nig = WGM * nN, gid = wgid / nig, fm = gid * WGM, gsz = (nM - fm) < WGM ? (nM - fm) : WGM;
        u.pm = fm + ((wgid % nig) % gsz); u.pn = (wgid % nig) / gsz; }
    __device__ bool next(int i, Unit& u) const {
        long L = (long)i * G + c;
        if (L < n1) { map((int)L, nM1, nN1, n1, u); return true; }
        L -= n1; if (L < n2) { map((int)L, nM2, nN2, n2, u); u.pm += pm2off; u.pn += pn2off; return true; }
        return false; }
    __device__ __forceinline__ void a_ready(const Unit&) const {}
    __device__ __forceinline__ void done(const Unit&) const {}
};
__device__ __forceinline__ unsigned cvt_pk_bf16(float lo, float hi) { unsigned r; asm volatile("v_cvt_pk_bf16_f32 %0, %1, %2" : "=v"(r) : "v"(lo), "v"(hi)); return r; }

struct EpiP {
    static constexpr bool PERM = true, AFTER_DRAIN = false;
    bf16_t* O; int ldc; const unsigned long long* SSi; const float* shw;
    __device__ __forceinline__ void operator()(const f32x4 (&acc)[2][2][4][2], const Unit& u, int wr, int wc, int fr, int fq) const {
        const int row0 = u.pm * BM + wr * 64 + fr, col0 = u.pn * BM + wc * 32 + 8 * fq;
        const float* sp = shw + (size_t)(u.pm < MLAT / BM ? (u.pm >> 3) : 8) * D_FF2 + col0;
        f32x4 sv[2][2];
#pragma unroll
        for (int bj = 0; bj < 2; ++bj)
#pragma unroll
            for (int n = 0; n < 2; ++n) sv[bj][n] = *(const f32x4*)(sp + bj * HALF + 4 * n);
#pragma unroll
        for (int ai = 0; ai < 2; ++ai)
#pragma unroll
            for (int m = 0; m < 4; ++m) { const int row = row0 + ai * HALF + m * 16; bf16_t* rowp = O + (size_t)row * ldc + col0;
                const float rs = rsqrtf((float)SSi[row] * SS_INV + EPS);
#pragma unroll
                for (int bj = 0; bj < 2; ++bj) { const f32x4 v0 = acc[ai][bj][m][0] * rs + sv[bj][0], v1 = acc[ai][bj][m][1] * rs + sv[bj][1];
                    u32x4 w; w.x = cvt_pk_bf16(v0[0], v0[1]); w.y = cvt_pk_bf16(v0[2], v0[3]); w.z = cvt_pk_bf16(v1[0], v1[1]); w.w = cvt_pk_bf16(v1[2], v1[3]);
                    *(u32x4*)(rowp + bj * HALF) = w; } }
    }
};
struct EpiRes {
    static constexpr bool PERM = false, AFTER_DRAIN = false;
    const float* base_lat; const float* base_ctx; float* out_lat; float* out_ctx; const float* gate;
    bf16_t* Hn; const float* ng; const float* scp; unsigned long long* SSo;
    __device__ __forceinline__ void operator()(const f32x4 (&acc)[2][2][4][2], const Unit& u, int wr, int wc, int fr, int fq) const {
        const bool lat = u.pm < MLAT / BM;
        const float* base = lat ? base_lat : base_ctx; float* out = lat ? out_lat : out_ctx;
        const int rb = (lat ? u.pm * BM : u.pm * BM - MLAT) + wr * 64 + fr, col0 = u.pn * BM + wc * 32 + 4 * fq;
        const int mr = lat ? (u.pm >> 3) : 8;
        const float* gp = gate + (size_t)mr * 6144 + col0;
        f32x4 gv[2][2], gs[2][2];
#pragma unroll
        for (int bj = 0; bj < 2; ++bj)
#pragma unroll
            for (int n = 0; n < 2; ++n) { gv[bj][n] = *(const f32x4*)(gp + bj * HALF + n * 16);
                if (Hn) gs[bj][n] = *(const f32x4*)(ng + col0 + bj * HALF + n * 16) * (1.f + *(const f32x4*)(scp + (size_t)mr * 6144 + col0 + bj * HALF + n * 16)); }
#pragma unroll
        for (int ai = 0; ai < 2; ++ai)
#pragma unroll
            for (int m = 0; m < 4; ++m) { const size_t off = (size_t)(rb + ai * HALF + m * 16) * DM + col0;
                const size_t grow = (size_t)(u.pm * BM + wr * 64 + fr + ai * HALF + m * 16);
                float ss = 0.f;
#pragma unroll
                for (int bj = 0; bj < 2; ++bj)
#pragma unroll
                    for (int n = 0; n < 2; ++n) { const f32x4 bs = *(const f32x4*)(base + off + bj * HALF + n * 16);
                        const f32x4 o = bs + gv[bj][n] * acc[ai][bj][m][n];
                        *(f32x4*)(out + off + bj * HALF + n * 16) = o;
                        if (Hn) { ss += (o[0] * o[0] + o[1] * o[1]) + (o[2] * o[2] + o[3] * o[3]); const f32x4 a = o * gs[bj][n];
                            uint2 w; w.x = cvt_pk_bf16(a[0], a[1]); w.y = cvt_pk_bf16(a[2], a[3]); *(uint2*)(Hn + grow * DM + col0 + bj * HALF + n * 16) = w; } }
                if (Hn) { ss += __shfl_xor(ss, 16); ss += __shfl_xor(ss, 32);
                    if (fq == 0) atomicAdd(SSo + grow, (unsigned long long)(ss * SS_SCALE + 0.5f)); } }
    }
};
__device__ __forceinline__ float lane_prev16(float x, int) { return __builtin_bit_cast(float, __builtin_amdgcn_update_dpp(0, __builtin_bit_cast(int, x), 0x121, 0xf, 0xf, false)); }
__device__ __forceinline__ float lane_next16(float x, int) { return __builtin_bit_cast(float, __builtin_amdgcn_update_dpp(0, __builtin_bit_cast(int, x), 0x12f, 0xf, 0xf, false)); }
struct EpiCG {
    static constexpr bool PERM = true, AFTER_DRAIN = false;
    bf16_t* G; float* RAW; const float* cw; const float* cb; const unsigned long long* SSi; const float* shw;
    __device__ __forceinline__ void operator()(const f32x4 (&acc)[2][2][4][2], const Unit& u, int wr, int wc, int fr, int fq) const {
        const int lane = fq * 16 + fr;
        float rs[2][4];
#pragma unroll
        for (int ai = 0; ai < 2; ++ai)
#pragma unroll
            for (int m = 0; m < 4; ++m) rs[ai][m] = rsqrtf((float)SSi[u.pm * BM + ai * HALF + wr * 64 + m * 16 + fr] * SS_INV + EPS);
        const float* sp = shw + (size_t)(u.pm < MLAT / BM ? (u.pm >> 3) : 8) * D_FF2;
#pragma unroll
        for (int n = 0; n < 2; ++n) {
            const int oc = u.pn * HALF + wc * 32 + 8 * fq + 4 * n;
            const int rg = u.pn * BM + wc * 32 + 8 * fq + 4 * n;
            const f32x4 w0g = *(const f32x4*)(cw + oc), w1g = *(const f32x4*)(cw + D_FF2 + oc), w2g = *(const f32x4*)(cw + 2 * D_FF2 + oc), bg = *(const f32x4*)(cb + oc);
            const f32x4 w0v = *(const f32x4*)(cw + D_FF + oc), w1v = *(const f32x4*)(cw + D_FF2 + D_FF + oc), w2v = *(const f32x4*)(cw + 2 * D_FF2 + D_FF + oc), bv = *(const f32x4*)(cb + D_FF + oc);
            const f32x4 shg = *(const f32x4*)(sp + rg), shv = *(const f32x4*)(sp + rg + HALF);
#pragma unroll
            for (int ai = 0; ai < 2; ++ai) {
                const int rowc = u.pm * BM + ai * HALF + wr * 64;
                const int chunk = rowc >> 6;
                f32x4 sg[4], sv[4];
#pragma unroll
                for (int m = 0; m < 4; ++m) { sg[m] = acc[ai][0][m][n] * rs[ai][m] + shg; sv[m] = acc[ai][1][m][n] * rs[ai][m] + shv; }
#pragma unroll
                for (int m = 0; m < 4; ++m) {
                    const f32x4 gc = sg[m], vc = sv[m];
                    const f32x4 gpm = sg[m > 0 ? m - 1 : 0], vpm = sv[m > 0 ? m - 1 : 0];
                    const f32x4 gnm = sg[m < 3 ? m + 1 : 3], vnm = sv[m < 3 ? m + 1 : 3];
                    f32x4 gp, gn, vp, vn;
#pragma unroll
                    for (int j = 0; j < 4; ++j) {
                        gp[j] = lane_prev16(fr == 15 ? gpm[j] : gc[j], lane); gn[j] = lane_next16(fr == 0 ? gnm[j] : gc[j], lane);
                        vp[j] = lane_prev16(fr == 15 ? vpm[j] : vc[j], lane); vn[j] = lane_next16(fr == 0 ? vnm[j] : vc[j], lane); }
                    const f32x4 cg = w0g * gp + w1g * gc + w2g * gn + bg, cv = w0v * vp + w1v * vc + w2v * vn + bv;
                    float o[4];
#pragma unroll
                    for (int j = 0; j < 4; ++j) o[j] = cg[j] * __builtin_amdgcn_rcpf(1.f + __expf(-cg[j])) * cv[j];
                    uint2 w; w.x = cvt_pk_bf16(o[0], o[1]); w.y = cvt_pk_bf16(o[2], o[3]);
                    *(uint2*)(G + (size_t)(rowc + m * 16 + fr) * D_FF + oc) = w;
                    if (m == 0 && fr < 2) { float* r = RAW + ((size_t)chunk * 4 + fr) * D_FF2 + rg; *(f32x4*)r = gc; *(f32x4*)(r + HALF) = vc; }
                    if (m == 3 && fr >= 14) { float* r = RAW + ((size_t)chunk * 4 + (fr - 12)) * D_FF2 + rg; *(f32x4*)r = gc; *(f32x4*)(r + HALF) = vc; }
                }
            }
        }
    }
};

template <class Epi, class Sched, bool ALIGN_EPI = false, bool SP2 = false>
__device__ __forceinline__ void gemm_phase(PG8_LAS unsigned char* lds, const Gemm g, const Sched& S, const Epi& E) {
    int tid_o = threadIdx.x; asm volatile("" : "+v"(tid_o));
    const int tid = tid_o, wid = __builtin_amdgcn_readfirstlane(tid >> 6), lane = tid & 63, wr = wid >> 2, wc = wid & 3, fr = lane & 15, fq = lane >> 4;
    const int K = g.K, nt = K / BK;
    unsigned voffA[2], voffB[2];
#pragma unroll
    for (int i = 0; i < 2; ++i) { int R, C; stage_rc(tid * 16 + i * 8192, R, C); const int Rb = Epi::PERM ? ((R & ~31) + perm32(R & 31)) : R;
        voffA[i] = (unsigned)(R * K + C) * 2u; voffB[i] = (unsigned)(Rb * K + C) * 2u; }
    const size_t kstep = (size_t)(BK * 2);
    const size_t hstep = (size_t)HALF * K * 2;
    const size_t tstep = 2 * hstep;
    const unsigned ldsw = (unsigned)wid * 1024u;
    const int aoff = lds_byte(wr * 64 + fr, fq * 8), boff = lds_byte(wc * 32 + fr, fq * 8);
#define PG8_SA(b, h) (((b) * 2 + (h)) * HTB)
#define PG8_SB(b, h) ((4 + (b) * 2 + (h)) * HTB)
#define PG8_STAGE(bufoff, gbase, voff) do { _Pragma("unroll") for (int _i = 0; _i < 2; ++_i) \
        __builtin_amdgcn_global_load_lds((const unsigned*)((const char*)(gbase) + (voff)[_i]), (PG8_LAS unsigned*)(lds + (bufoff) + ldsw + _i * 8192), 16, 0, 0); } while (0)
#define PG8_LDA(dst, b, h) do { _Pragma("unroll") for (int m = 0; m < 4; ++m) _Pragma("unroll") for (int k = 0; k < 2; ++k) dst[m][k] = *(const PG8_LAS bf16x8*)(lds + PG8_SA(b, h) + aoff + m * 2048 + k * 1024); } while (0)
#define PG8_LDB(dst, b, h) do { _Pragma("unroll") for (int n = 0; n < 2; ++n) _Pragma("unroll") for (int k = 0; k < 2; ++k) dst[n][k] = *(const PG8_LAS bf16x8*)(lds + PG8_SB(b, h) + boff + n * 2048 + k * 1024); } while (0)
#define PG8_MMA(ai, bj, At, Bt) do { __builtin_amdgcn_s_setprio(1); _Pragma("unroll") for (int m = 0; m < 4; ++m) _Pragma("unroll") for (int n = 0; n < 2; ++n) _Pragma("unroll") for (int k = 0; k < 2; ++k) \
        acc[ai][bj][m][n] = __builtin_amdgcn_mfma_f32_16x16x32_bf16(Bt[n][k], At[m][k], acc[ai][bj][m][n], 0, 0, 0); __builtin_amdgcn_s_setprio(0); } while (0)
#define PG8_WAIT_V(n) asm volatile("s_waitcnt vmcnt(" #n ")" ::: "memory")
#define PG8_WAIT_L(n) asm volatile("s_waitcnt lgkmcnt(" #n ")" ::: "memory")
#define PG8_BAR __builtin_amdgcn_s_barrier()
#define PG8_SCHED __builtin_amdgcn_sched_barrier(0)
    Unit cur, nxt; int ui = 0;
    if (!S.next(0, cur)) return;
    f32x4 acc[2][2][4][2];
#pragma unroll
    for (int a = 0; a < 2; ++a)
#pragma unroll
        for (int b = 0; b < 2; ++b)
#pragma unroll
            for (int m = 0; m < 4; ++m)
#pragma unroll
                for (int n = 0; n < 2; ++n) acc[a][b][m][n] = (f32x4){0.f, 0.f, 0.f, 0.f};
    bf16x8 At[4][2], B0[2][2], B1[2][2];
    const char* cA = (const char*)g.A + (size_t)cur.pm * tstep; const char* cB = (const char*)g.Bt + (size_t)cur.pn * tstep;
    S.a_ready(cur);
    if constexpr (SP2) {
        PG8_STAGE(PG8_SB(0, 0), cB, voffB); PG8_STAGE(PG8_SB(0, 1), cB + hstep, voffB); PG8_STAGE(PG8_SA(0, 0), cA, voffA); PG8_STAGE(PG8_SA(0, 1), cA + hstep, voffA);
        if (wr == 1) PG8_BAR;
        PG8_WAIT_V(2); PG8_BAR;
        PG8_STAGE(PG8_SB(1, 0), cB + kstep, voffB); PG8_STAGE(PG8_SA(1, 0), cA + kstep, voffA); PG8_STAGE(PG8_SB(1, 1), cB + hstep + kstep, voffB);
        PG8_WAIT_V(6); PG8_BAR;
    } else {
        PG8_STAGE(PG8_SB(0, 0), cB, voffB); PG8_STAGE(PG8_SA(0, 0), cA, voffA); PG8_STAGE(PG8_SB(0, 1), cB + hstep, voffB); PG8_STAGE(PG8_SA(0, 1), cA + hstep, voffA);
        if (wr == 1) PG8_BAR;
        PG8_WAIT_V(4); PG8_BAR;
        PG8_STAGE(PG8_SB(1, 0), cB + kstep, voffB); PG8_STAGE(PG8_SA(1, 0), cA + kstep, voffA); PG8_STAGE(PG8_SB(1, 1), cB + hstep + kstep, voffB);
        PG8_WAIT_V(6); PG8_BAR;
    }
    for (;;) {
        const bool has_next = S.next(ui + 1, nxt);
        const char* nA = has_next ? (const char*)g.A + (size_t)nxt.pm * tstep : cA; const char* nB = has_next ? (const char*)g.Bt + (size_t)nxt.pn * tstep : cB;
        for (int t = 0; t < nt; t += 2) {
            const bool last = (t == nt - 2);
            const char* a1 = cA + (size_t)(t + 1) * kstep;
            const char* a2 = last ? nA : cA + (size_t)(t + 2) * kstep; const char* b2 = last ? nB : cB + (size_t)(t + 2) * kstep;
            const char* a3 = a2 + kstep; const char* b3 = b2 + kstep;
            if (last && has_next) S.a_ready(nxt);
            if constexpr (SP2) {
            PG8_LDB(B0, 0, 0); PG8_LDB(B1, 0, 1); PG8_SCHED; PG8_LDA(At, 0, 0); PG8_STAGE(PG8_SA(1, 1), a1 + hstep, voffA);
            PG8_WAIT_V(8); PG8_WAIT_L(0); PG8_BAR; PG8_MMA(0, 0, At, B0); PG8_MMA(0, 1, At, B1); PG8_BAR; PG8_SCHED;
            PG8_LDA(At, 0, 1); PG8_STAGE(PG8_SB(0, 0), b2, voffB); PG8_STAGE(PG8_SB(0, 1), b2 + hstep, voffB); PG8_STAGE(PG8_SA(0, 0), a2, voffA);
            PG8_WAIT_V(8); PG8_WAIT_L(0); PG8_BAR; PG8_MMA(1, 0, At, B0); PG8_MMA(1, 1, At, B1); PG8_BAR; PG8_SCHED;
            PG8_LDB(B0, 1, 0); PG8_LDB(B1, 1, 1); PG8_SCHED; PG8_LDA(At, 1, 0); PG8_STAGE(PG8_SA(0, 1), a2 + hstep, voffA);
            PG8_WAIT_V(8); PG8_WAIT_L(0); PG8_BAR; PG8_MMA(0, 0, At, B0); PG8_MMA(0, 1, At, B1); PG8_BAR; PG8_SCHED;
            PG8_LDA(At, 1, 1); PG8_STAGE(PG8_SB(1, 0), b3, voffB); PG8_STAGE(PG8_SB(1, 1), b3 + hstep, voffB); PG8_STAGE(PG8_SA(1, 0), a3, voffA);
            PG8_WAIT_V(8); PG8_WAIT_L(0); PG8_BAR; PG8_MMA(1, 0, At, B0); PG8_MMA(1, 1, At, B1); PG8_BAR; PG8_SCHED;
            } else {
            PG8_LDB(B0, 0, 0); PG8_SCHED; PG8_LDA(At, 0, 0); PG8_STAGE(PG8_SA(1, 1), a1 + hstep, voffA);
            PG8_WAIT_L(8); PG8_BAR; PG8_WAIT_L(0); PG8_MMA(0, 0, At, B0); PG8_BAR; PG8_SCHED;
            PG8_LDB(B1, 0, 1); PG8_STAGE(PG8_SB(0, 0), b2, voffB);
            PG8_BAR; PG8_WAIT_L(0); PG8_MMA(0, 1, At, B1); PG8_BAR;
            PG8_LDA(At, 0, 1); PG8_STAGE(PG8_SA(0, 0), a2, voffA);
            PG8_BAR; PG8_WAIT_L(0); PG8_MMA(1, 0, At, B0); PG8_BAR; PG8_SCHED;
            PG8_STAGE(PG8_SB(0, 1), b2 + hstep, voffB);
            PG8_WAIT_V(6); PG8_BAR; PG8_MMA(1, 1, At, B1); PG8_BAR;
            PG8_LDB(B0, 1, 0); PG8_SCHED; PG8_LDA(At, 1, 0); PG8_STAGE(PG8_SA(0, 1), a2 + hstep, voffA);
            PG8_WAIT_L(8); PG8_BAR; PG8_WAIT_L(0); PG8_MMA(0, 0, At, B0); PG8_BAR; PG8_SCHED;
            PG8_LDB(B1, 1, 1); PG8_STAGE(PG8_SB(1, 0), b3, voffB);
            PG8_BAR; PG8_WAIT_L(0); PG8_MMA(0, 1, At, B1); PG8_BAR;
            PG8_LDA(At, 1, 1); PG8_STAGE(PG8_SA(1, 0), a3, voffA);
            PG8_BAR; PG8_WAIT_L(0); PG8_MMA(1, 0, At, B0); PG8_BAR; PG8_SCHED;
            PG8_STAGE(PG8_SB(1, 1), b3 + hstep, voffB);
            PG8_WAIT_V(6); PG8_BAR; PG8_MMA(1, 1, At, B1); PG8_BAR;
            }
        }
        if constexpr (ALIGN_EPI) { if (wr == 0) PG8_BAR; }
        if constexpr (!Epi::AFTER_DRAIN) { E(acc, cur, wr, wc, fr, fq); S.done(cur); }
        if (!has_next) break;
#pragma unroll
        for (int a = 0; a < 2; ++a)
#pragma unroll
            for (int b = 0; b < 2; ++b)
#pragma unroll
                for (int m = 0; m < 4; ++m)
#pragma unroll
                    for (int n = 0; n < 2; ++n) acc[a][b][m][n] = (f32x4){0.f, 0.f, 0.f, 0.f};
        cur = nxt; cA = nA; cB = nB; ++ui;
        if constexpr (ALIGN_EPI) { if (wr == 1) PG8_BAR; }
    }
    PG8_WAIT_V(0);
    if constexpr (!ALIGN_EPI) { if (wr == 0) PG8_BAR; }
    PG8_BAR;
    if constexpr (Epi::AFTER_DRAIN) { E.fused(acc, cur, wr, wc, fr, fq, lds, wid, lane); S.done(cur); }
#undef PG8_SA
#undef PG8_SB
#undef PG8_STAGE
#undef PG8_LDA
#undef PG8_LDB
#undef PG8_MMA
#undef PG8_WAIT_V
#undef PG8_WAIT_L
#undef PG8_BAR
#undef PG8_SCHED
}

#define GAS __attribute__((address_space(1)))
#define LAS __attribute__((address_space(3)))
typedef unsigned v4u __attribute__((ext_vector_type(4)));
typedef GAS unsigned gu32;
typedef GAS unsigned long long gu64;
#define RLX_AGENT __ATOMIC_RELAXED, __HIP_MEMORY_SCOPE_AGENT
#define LDS_WAIT() asm volatile("s_waitcnt lgkmcnt(0)" ::: "memory")
#define VM_WAIT() asm volatile("s_waitcnt vmcnt(0)" ::: "memory")
__device__ __forceinline__ unsigned long long rt() { return __builtin_amdgcn_s_memrealtime(); }

#define XB_TMO      128
#define XB_XCNT(j)  (256  + 64 * (j))
#define XB_XSUB(j)  (1280 + 64 * (j))
#define XB_XGEN(j)  (2304 + 64 * (j))
#define XB_TOP      3328
#define XB_TOPGEN   3392
#define XCD_BAR_WORDS 3456
#define XB_SPIN_CAP (1u << 18)

__device__ __forceinline__ unsigned xb_ld(unsigned* p)              { return __hip_atomic_load(p, __ATOMIC_RELAXED, __HIP_MEMORY_SCOPE_AGENT); }
__device__ __forceinline__ unsigned xb_add(unsigned* p, unsigned v) { return __hip_atomic_fetch_add(p, v, __ATOMIC_RELAXED, __HIP_MEMORY_SCOPE_AGENT); }
__device__ __forceinline__ unsigned xb_xcc_id() { return (unsigned)__builtin_amdgcn_s_getreg((3 << 11) | 20) & 0xFu; }
#define XB_SPIN(cond, bar) do { unsigned _sp = 0; while (cond) { __builtin_amdgcn_s_sleep(1); \
    if ((++_sp & 255u) == 0u) { if (xb_ld(&(bar)[XB_TMO])) break; if (_sp > XB_SPIN_CAP) { atomicAdd(&(bar)[XB_TMO], 1u); break; } } } } while (0)

struct XcdBarrier {
    unsigned* bar; unsigned x;
    volatile LAS unsigned* st;
};

__device__ __forceinline__ XcdBarrier xcd_barrier_post(unsigned* bar, volatile LAS unsigned* st) {
    XcdBarrier b; b.bar = bar; b.x = xb_xcc_id(); b.st = st;
    if (threadIdx.x == 0) (void)xb_add(&bar[XB_XCNT(b.x)], 1u);
    return b;
}
__device__ __forceinline__ void xcd_barrier_complete(unsigned* bar, unsigned x, unsigned& nloc, unsigned& nx) {
    const unsigned G = gridDim.x * gridDim.y * gridDim.z;
    unsigned sum, cnt, mine, sp = 0u;
    for (;;) {
        sum = 0u; cnt = 0u; mine = 0u;
#pragma unroll
        for (unsigned j = 0; j < 16; ++j) { const unsigned c = xb_ld(&bar[XB_XCNT(j)]); sum += c; cnt += (c > 0u) ? 1u : 0u; mine = (j == x) ? c : mine; }
        if (sum == G) break;
        __builtin_amdgcn_s_sleep(1);
        if ((++sp & 255u) == 0u) { if (xb_ld(&bar[XB_TMO])) break; if (sp > XB_SPIN_CAP) { atomicAdd(&bar[XB_TMO], 1u); break; } }
    }
    nloc = mine > 0u ? mine : 1u; nx = cnt > 0u ? cnt : 1u;
}

__device__ __forceinline__ void xcd_barrier(const XcdBarrier& b) {
    asm volatile("s_waitcnt vmcnt(0)" ::: "memory");
    __syncthreads();
    if (threadIdx.x == 0) {
        unsigned* bar = b.bar;
        __builtin_amdgcn_s_waitcnt(0);
        unsigned nloc = b.st[0], nx = b.st[1];
        if (nloc == 0u) { xcd_barrier_complete(bar, b.x, nloc, nx); b.st[0] = nloc; b.st[1] = nx; }
        const unsigned old = xb_add(&bar[XB_XSUB(b.x)], 1u);
        const unsigned gen = old / nloc;
        if (old + 1u == (gen + 1u) * nloc) {
            __builtin_amdgcn_fence(__ATOMIC_RELEASE, "agent");
            asm volatile("s_waitcnt vmcnt(0)" ::: "memory");
            const unsigned og = xb_add(&bar[XB_TOP], 1u);
            const unsigned tg = og / nx;
            if (og + 1u == (tg + 1u) * nx) xb_add(&bar[XB_TOPGEN], 1u);
            else XB_SPIN(xb_ld(&bar[XB_TOPGEN]) == tg, bar);
            __builtin_amdgcn_fence(__ATOMIC_ACQUIRE, "agent");
            xb_add(&bar[XB_XGEN(b.x)], 1u);
            asm volatile("s_waitcnt vmcnt(0)" ::: "memory");
        } else {
            XB_SPIN(xb_ld(&bar[XB_XGEN(b.x)]) == gen, bar);
            __builtin_amdgcn_fence(__ATOMIC_ACQUIRE, "agent");
            asm volatile("s_waitcnt vmcnt(0)" ::: "memory");
        }
    }
    __syncthreads();
}

typedef LAS float lfloat;
__device__ __forceinline__ void transpose_item_l(const float* W, int K, int N, bf16_t* WT, bool upperm, lfloat* scr, int item, int lane) {
    const int nblk = N / 32, kb = item / nblk, nb = item % nblk, k0 = 64 * kb, n0 = 32 * nb;
    int r0 = n0;
    if (upperm) { r0 = (n0 < D_FF) ? (256 * (n0 / 128) + (n0 % 128)) : (256 * ((n0 - D_FF) / 128) + 128 + ((n0 - D_FF) % 128)); }
#pragma unroll 8
    for (int i = 0; i < 32; ++i) { const int kk = 2 * i + (lane >> 5); scr[kk * 33 + (lane & 31)] = W[(size_t)(k0 + kk) * N + n0 + (lane & 31)]; }
    asm volatile("s_waitcnt lgkmcnt(0)" ::: "memory");
    const int c = lane & 7;
#pragma unroll
    for (int j = 0; j < 4; ++j) { const int n = (lane >> 3) + 8 * j; const lfloat* s = scr + (8 * c) * 33 + n;
        u32x4 o; o.x = pk2(s[0 * 33], s[1 * 33]); o.y = pk2(s[2 * 33], s[3 * 33]); o.z = pk2(s[4 * 33], s[5 * 33]); o.w = pk2(s[6 * 33], s[7 * 33]);
        *(u32x4*)(WT + (size_t)(r0 + n) * K + k0 + 8 * c) = o; }
    asm volatile("s_waitcnt lgkmcnt(0)" ::: "memory");
}
__device__ __forceinline__ void wconv_phase(const Params& p, LAS unsigned char* lds, int vcu, int G) {
    int tid_o = threadIdx.x; asm volatile("" : "+v"(tid_o));
    const int lane = tid_o & 63, wave = __builtin_amdgcn_readfirstlane(tid_o >> 6);
    lfloat* scr = (lfloat*)lds + wave * 64 * 33;
    const int gw = vcu * NWAVES + wave, NGW = G * NWAVES;
    constexpr int I_IN = (DM / 64) * (D_IN / 32), I_OUT = (DM / 64) * (DM / 32), I_UP = (DM / 64) * (D_FF2 / 32), I_DN = (D_FF / 64) * (DM / 32);
    constexpr int PER_L = I_IN + I_OUT + I_UP + I_DN;
    for (int it = gw; it < DEPTH * PER_L; it += NGW) {
        const int l = it / PER_L; int r = it % PER_L;
        if (r < I_IN) { transpose_item_l(p.in[7] + (size_t)l * DM * D_IN, DM, D_IN, (bf16_t*)(p.ws + WS_WIN) + (size_t)l * D_IN * DM, false, scr, r, lane); continue; } r -= I_IN;
        if (r < I_OUT) { transpose_item_l(p.in[28] + (size_t)l * DM * DM, DM, DM, (bf16_t*)(p.ws + WS_WOUT) + (size_t)l * DM * DM, false, scr, r, lane); continue; } r -= I_OUT;
        if (r < I_UP) { transpose_item_l(p.in[30] + (size_t)l * DM * D_FF2, DM, D_FF2, (bf16_t*)(p.ws + WS_WUP) + (size_t)l * D_FF2 * DM, true, scr, r, lane); continue; } r -= I_UP;
        transpose_item_l(p.in[33] + (size_t)l * D_FF * DM, D_FF, DM, (bf16_t*)(p.ws + WS_WDN) + (size_t)l * DM * D_FF, false, scr, r, lane);
    }
    __syncthreads();
}
__device__ __forceinline__ void mod_phase(const Params& p, LAS unsigned char* lds, int vcu, int G) {
    int tid_o = threadIdx.x; asm volatile("" : "+v"(tid_o));
    const int tid = tid_o;
    lfloat* s = (lfloat*)lds;
    float* part = (float*)(p.ws + WS_A);
    for (int item = vcu; item < DEPTH * 32 * 12; item += G) {
        const int l = item / (32 * 12), rem = item % (32 * 12), kc = rem / 12, nc = rem % 12;
        const int k0 = kc * 32, n = nc * 512 + tid;
        __syncthreads();
        if (tid < 9 * 32) { const int r = tid / 32, kk = tid % 32;
            const float v = (r < 8) ? p.in[1][(size_t)r * DM + k0 + kk] : p.in[3][k0 + kk]; s[r * 32 + kk] = silu_f(v); }
        __syncthreads();
        float acc[9];
#pragma unroll
        for (int r = 0; r < 9; ++r) acc[r] = 0.f;
        const float* W = p.in[4] + ((size_t)l * DM + k0) * 6144 + n;
#pragma unroll 8
        for (int kk = 0; kk < 32; ++kk) { const float w = W[(size_t)kk * 6144];
#pragma unroll
            for (int r = 0; r < 9; ++r) acc[r] += s[r * 32 + kk] * w; }
#pragma unroll
        for (int r = 0; r < 9; ++r) part[(((size_t)l * 32 + kc) * 9 + r) * 6144 + n] = acc[r];
    }
    __syncthreads();
}
__device__ __forceinline__ void modred_phase(const Params& p, int vcu, int G) {
    const float* part = (const float*)(p.ws + WS_A);
    float* mod = (float*)(p.ws + WS_MOD);
    for (int e = vcu * 512 + (int)threadIdx.x; e < DEPTH * 9 * 6144; e += G * 512) {
        const int l = e / (9 * 6144), rn = e % (9 * 6144);
        float a = p.in[5][(size_t)l * 6144 + rn % 6144];
        for (int kc = 0; kc < 32; ++kc) a += part[((size_t)l * 32 + kc) * 9 * 6144 + rn];
        mod[e] = a;
    }
}
__device__ __forceinline__ void filters_item(const Params& p, lfloat* z, lfloat* h1, lfloat* h2, int tid, int l, int L, int pos0, int np, bool vec, bf16_t* R) {
    const int FLEN = 2 * L;
    const float* w1 = p.in[10] + (size_t)l * HY_EMB * HY_FFN; const float* b1 = p.in[11] + (size_t)l * HY_FFN;
    const float* w2 = p.in[12] + (size_t)l * HY_FFN * HY_FFN; const float* b2 = p.in[13] + (size_t)l * HY_FFN;
    const float* w3 = p.in[14] + (size_t)l * HY_FFN * 1024; const float* fr = p.in[15] + (size_t)l * HY_FFN;
    __syncthreads();
    for (int e = tid; e < np * HY_EMB; e += 512) { const int pp = e / HY_EMB, f = e % HY_EMB; const int pos = pos0 + pp;
        float v;
        if (f == 0) v = (float)pos / (float)(L - 1);
        else { const int k = (f - 1) & 15; const float band = 1e-4f + (float)k * ((15.f - 1e-4f) / 15.f);
               const float w = 6.283185307179586f * (float)pos / (float)L; const float a = band * w;
               v = (f <= 16) ? cosf(a) : -sinf(a); }
        z[pp * 34 + f] = v; }
    __syncthreads();
    for (int e = tid; e < np * HY_FFN; e += 512) { const int pp = e / HY_FFN, j = e % HY_FFN; float a = b1[j];
#pragma unroll 11
        for (int i = 0; i < HY_EMB; ++i) a += z[pp * 34 + i] * w1[i * HY_FFN + j];
        h1[pp * 64 + j] = sinf(fr[j] * a); }
    __syncthreads();
    for (int e = tid; e < np * HY_FFN; e += 512) { const int pp = e / HY_FFN, j = e % HY_FFN; float a = b2[j];
#pragma unroll 16
        for (int i = 0; i < HY_FFN; ++i) a += h1[pp * 64 + i] * w2[i * HY_FFN + j];
        h2[pp * 64 + j] = sinf(fr[j] * a); }
    __syncthreads();
    for (int o = tid; o < 1024; o += 512) {
        float acc[17];
#pragma unroll
        for (int pp = 0; pp < 17; ++pp) acc[pp] = 0.f;
        for (int k0 = 0; k0 < HY_FFN; k0 += 8) {
            float w[8];
#pragma unroll
            for (int k = 0; k < 8; ++k) w[k] = w3[(k0 + k) * 1024 + o];
#pragma unroll
            for (int pp = 0; pp < 17; ++pp) { const f32x4 ha = *(LAS const f32x4*)(h2 + pp * 64 + k0), hb = *(LAS const f32x4*)(h2 + pp * 64 + k0 + 4);
                acc[pp] += (ha.x * w[0] + ha.y * w[1]) + (ha.z * w[2] + ha.w * w[3]) + (hb.x * w[4] + hb.y * w[5]) + (hb.z * w[6] + hb.w * w[7]); }
        }
        const int order = o >> 9, dir = (o >> 8) & 1, c = o & 255;
        const float mind = -4.605170185988091f / 1.5f, maxd = -4.605170185988091f / 0.3f;
        const float delta = fabsf(mind + (float)c * ((maxd - mind) / 255.f));
        bf16_t* Rc = R + ((size_t)order * D_HY + c) * FLEN;
        float v[17];
#pragma unroll
        for (int pp = 0; pp < 17; ++pp) { const float t = (float)(pos0 + pp) / (float)(L - 1); v[pp] = acc[pp] * __expf(-t * delta); }
        if (vec) {
            if (dir == 0) {
                u32x4 a0, a1;
                a0.x = pk2(v[15], v[14]); a0.y = pk2(v[13], v[12]); a0.z = pk2(v[11], v[10]); a0.w = pk2(v[9], v[8]);
                a1.x = pk2(v[7], v[6]); a1.y = pk2(v[5], v[4]); a1.z = pk2(v[3], v[2]); a1.w = pk2(v[1], v[0]);
                bf16_t* d = Rc + (L - 16 - pos0); *(u32x4*)d = a0; *(u32x4*)(d + 8) = a1;
            } else {
                if (pos0 + 16 >= L) v[16] = 0.f;
                u32x4 a0, a1;
                a0.x = pk2(v[1], v[2]); a0.y = pk2(v[3], v[4]); a0.z = pk2(v[5], v[6]); a0.w = pk2(v[7], v[8]);
                a1.x = pk2(v[9], v[10]); a1.y = pk2(v[11], v[12]); a1.z = pk2(v[13], v[14]); a1.w = pk2(v[15], v[16]);
                bf16_t* d = Rc + (L + pos0); *(u32x4*)d = a0; *(u32x4*)(d + 8) = a1;
            }
        } else {
            const int pos = pos0;
            if (dir == 0) Rc[L - 1 - pos] = (bf16_t)f2bf(v[0]);
            else if (pos > 0) Rc[L - 1 + pos] = (bf16_t)f2bf(v[0]);
            if (pos0 == 0 && dir == 0) Rc[FLEN - 1] = 0;
        }
    }
}
__device__ __forceinline__ void filters_phase(const Params& p, LAS unsigned char* lds, int vcu, int G) {
    int tid_o = threadIdx.x; asm volatile("" : "+v"(tid_o));
    const int tid = tid_o;
    lfloat* z = (lfloat*)lds;
    lfloat* h1 = z + 17 * 34 + 2;
    lfloat* h2 = h1 + 17 * 64;
    for (int e = tid; e < 580 + 2 * 17 * 64; e += 512) z[e] = 0.f;
    for (int item = vcu; item < 512; item += G) {
        if (item < 256) { const int l = item >> 7; const int pos0 = (item & 127) * 16;
            filters_item(p, z, h1, h2, tid, l, SEQ, pos0, pos0 + 17 <= SEQ ? 17 : 16, true, (bf16_t*)(p.ws + WS_FILT) + (size_t)l * 2 * D_HY * FL); }
        else filters_item(p, z, h1, h2, tid, 0, CTXL, item - 256, 1, false, (bf16_t*)(p.ws + WS_FILTC));
    }
    __syncthreads();
    float* tab = (float*)(p.ws + WS_ROPE);
    for (int e = vcu * 512 + tid; e < SEQ * 32; e += G * 512) {
        const int pos = e >> 5, axis = (e >> 4) & 1, pr = e & 15;
        const float inv = exp2f(-(float)pr * (13.287712379549449f / 16.f));
        const float coord = axis == 0 ? (float)(pos / 64) : (float)(pos % 64);
        const float a = coord * inv;
        tab[2 * e] = cosf(a); tab[2 * e + 1] = sinf(a);
    }
}
__device__ __forceinline__ void norm0_phase(const Params& p, int vcu, int G) {
    int tid_o = threadIdx.x; asm volatile("" : "+v"(tid_o));
    const int lane = tid_o & 63, gw = vcu * NWAVES + (tid_o >> 6), NGW = G * NWAVES;
    const float* g = p.in[6];
    bf16_t* H = (bf16_t*)(p.ws + WS_HBF);
    unsigned long long* SS = (unsigned long long*)(p.ws + WS_SS);
    const float* MODl = (const float*)(p.ws + WS_MOD);
    f32x4 gv[4];
#pragma unroll
    for (int j = 0; j < 4; ++j) gv[j] = *(const f32x4*)(g + 4 * lane + 256 * j);
    for (int row = gw; row < MTOT; row += NGW) {
        const float* src; int mr;
        if (row < MLAT) { mr = row / SEQ; src = p.in[0] + (size_t)row * DM; }
        else { mr = 8; src = p.in[2] + (size_t)(row - MLAT) * DM; }
        f32x4 v[4]; float ss = 0.f;
#pragma unroll
        for (int j = 0; j < 4; ++j) { v[j] = *(const f32x4*)(src + 4 * lane + 256 * j); ss += (v[j].x * v[j].x + v[j].y * v[j].y) + (v[j].z * v[j].z + v[j].w * v[j].w); }
#pragma unroll
        for (int o = 1; o < 64; o <<= 1) ss += __shfl_xor(ss, o);
        if (lane == 0) SS[row] = (unsigned long long)(ss * SS_SCALE + 0.5f);
        const float* mrow = MODl + (size_t)mr * 6144;
#pragma unroll
        for (int j = 0; j < 4; ++j) { const int col = 4 * lane + 256 * j;
            const f32x4 sc = *(const f32x4*)(mrow + 1024 + col);
            const f32x4 y = v[j] * gv[j] * (1.f + sc);
            uint2 w; w.x = pk2(y.x, y.y); w.y = pk2(y.z, y.w);
            *(uint2*)(H + (size_t)row * DM + col) = w; }
    }
}
__device__ __forceinline__ void shw_phase(const Params& p, LAS unsigned char* lds, int vcu, int G) {
    typedef float f32x16 __attribute__((ext_vector_type(16)));
    int tid_o = threadIdx.x; asm volatile("" : "+v"(tid_o));
    const int tid = tid_o, lane = tid & 63, gw = vcu * NWAVES + (tid >> 6), NGW = G * NWAVES;
    LAS bf16_t* sh = (LAS bf16_t*)lds;
    __syncthreads();
    for (int e = tid; e < 4 * 16 * 1024; e += 512) { const int combo = e >> 14, r = (e >> 10) & 15, k = e & 1023;
        const float v = r < 9 ? ((const float*)(p.ws + WS_MOD))[((size_t)(combo >> 1) * 9 + r) * 6144 + ((combo & 1) ? 3072 : 0) + k] : 0.f;
        sh[e] = (bf16_t)f2bf(v); }
    __syncthreads();
    constexpr int T_IN = D_IN / 32, T_UP = D_FF2 / 32, T_L = T_IN + T_UP;
    const int r = lane & 31, h = lane >> 5;
    for (int task = gw; task < DEPTH * T_L; task += NGW) {
        const int l = task / T_L, tt = task % T_L, which = tt >= T_IN ? 1 : 0, n0 = (which ? tt - T_IN : tt) * 32, combo = l * 2 + which;
        const bf16_t* Wt = (which ? (const bf16_t*)(p.ws + WS_WUP) + (size_t)l * D_FF2 * DM : (const bf16_t*)(p.ws + WS_WIN) + (size_t)l * D_IN * DM) + (size_t)(n0 + r) * DM + 8 * h;
        LAS const bf16_t* ap = sh + ((size_t)combo * 16 + (r & 15)) * 1024 + 8 * h;
        f32x16 acc;
#pragma unroll
        for (int i = 0; i < 16; ++i) acc[i] = 0.f;
#pragma unroll 8
        for (int ks = 0; ks < 64; ++ks) { const bf16x8 bfr = *(const bf16x8*)(Wt + 16 * ks); const bf16x8 afr = *(LAS const bf16x8*)(ap + 16 * ks);
            acc = __builtin_amdgcn_mfma_f32_32x32x16_bf16(afr, bfr, acc, 0, 0, 0); }
        float* dst = (float*)(p.ws + WS_SHW) + (size_t)combo * 9 * D_FF2 + n0 + r;
#pragma unroll
        for (int i = 0; i < 4; ++i) dst[(size_t)(i + 4 * h) * D_FF2] = acc[i];
        if (h == 0) dst[(size_t)8 * D_FF2] = acc[4];
    }
    __syncthreads();
}
__device__ __forceinline__ void prep_qk_phase(const Params& p, int l, int nrows, int vcu, int G) {
    int tid_o = threadIdx.x; asm volatile("" : "+v"(tid_o));
    const int lane = tid_o & 63, gw = vcu * NWAVES + (tid_o >> 6), NGW = G * NWAVES;
    bf16_t* P = (bf16_t*)(p.ws + WS_A);
    const float* tab = (const float*)(p.ws + WS_ROPE);
    const int v = lane >> 2, quarter = lane & 3, axis = quarter >> 1, half = quarter & 1;
    const float* gn = (v < 8 ? p.in[21] : p.in[22]) + (size_t)l * QKD + quarter * 16;
    float g[16];
#pragma unroll
    for (int i = 0; i < 16; ++i) g[i] = gn[i];
    for (int row = gw; row < nrows; row += NGW) {
        bf16_t* ptr = P + (size_t)row * D_IN + COL_Q + v * 64 + quarter * 16;
        const u32x4 w0 = *(const u32x4*)ptr, w1 = *(const u32x4*)(ptr + 8);
        float x[16];
        x[0] = bflo(w0.x); x[1] = bfhi(w0.x); x[2] = bflo(w0.y); x[3] = bfhi(w0.y); x[4] = bflo(w0.z); x[5] = bfhi(w0.z); x[6] = bflo(w0.w); x[7] = bfhi(w0.w);
        x[8] = bflo(w1.x); x[9] = bfhi(w1.x); x[10] = bflo(w1.y); x[11] = bfhi(w1.y); x[12] = bflo(w1.z); x[13] = bfhi(w1.z); x[14] = bflo(w1.w); x[15] = bfhi(w1.w);
        float ss = 0.f;
#pragma unroll
        for (int i = 0; i < 16; ++i) ss += x[i] * x[i];
        ss += __shfl_xor(ss, 1); ss += __shfl_xor(ss, 2);
        const float rstd = rsqrtf(ss * (1.f / QKD) + EPS);
        float y[16];
#pragma unroll
        for (int i = 0; i < 16; ++i) y[i] = x[i] * rstd * g[i];
        if (row < MLAT) {
            const int pos = row % SEQ;
            const float* tp = tab + ((size_t)pos * 2 + axis) * 32;
#pragma unroll
            for (int i = 0; i < 16; ++i) { const float other = __shfl_xor(y[i], 1); const float c = tp[2 * i], s = tp[2 * i + 1];
                y[i] = half == 0 ? (y[i] * c - other * s) : (y[i] * c + other * s); }
        }
        const float sc = v < 8 ? QSCALE : 1.f;
        u32x4 o0, o1;
        o0.x = pk2(y[0] * sc, y[1] * sc); o0.y = pk2(y[2] * sc, y[3] * sc); o0.z = pk2(y[4] * sc, y[5] * sc); o0.w = pk2(y[6] * sc, y[7] * sc);
        o1.x = pk2(y[8] * sc, y[9] * sc); o1.y = pk2(y[10] * sc, y[11] * sc); o1.z = pk2(y[12] * sc, y[13] * sc); o1.w = pk2(y[14] * sc, y[15] * sc);
        *(u32x4*)ptr = o0; *(u32x4*)(ptr + 8) = o1;
    }
}
constexpr int HYP_LD = 72;
__device__ __forceinline__ void prep_hy_phase(const Params& p, int l, bool with_ctx, LAS unsigned char* lds, int vcu, int G) {
    int tid_o = threadIdx.x; asm volatile("" : "+v"(tid_o));
    const int tid = tid_o;
    LAS bf16_t* T = (LAS bf16_t*)lds;
    const bf16_t* P = (const bf16_t*)(p.ws + WS_A);
    const float* cw = p.in[8] + (size_t)l * 3 * IN_A; const float* cb = p.in[9] + (size_t)l * IN_A;
    const int nitems = 256 * 12 + (with_ctx ? 32 * 12 : 0);
    for (int item = vcu; item < nitems; item += G) {
        int b, t0, L, ct; size_t rowbase; bf16_t* dst; size_t which_stride;
        if (item < 256 * 12) { const int it = item / 12; ct = item % 12; b = it >> 5; t0 = (it & 31) * 64; L = SEQ; rowbase = (size_t)b * SEQ; dst = (bf16_t*)(p.ws + WS_HYT); which_stride = HYT_LAT_ELEMS; }
        else { const int it = (item - 256 * 12) / 12; ct = (item - 256 * 12) % 12; b = it >> 2; t0 = (it & 3) * 64; L = CTXL; rowbase = (size_t)MLAT + (size_t)b * CTXL; dst = (bf16_t*)(p.ws + WS_HYTC); which_stride = HYT_CTX_ELEMS; }
        __syncthreads();
        for (int ch = tid; ch < 66 * 8; ch += 512) { const int i = ch >> 3, part = ch & 7, t = t0 - 1 + i;
            u32x4 v = {0u, 0u, 0u, 0u};
            if (t >= 0 && t < L) v = *(const u32x4*)(P + (rowbase + t) * D_IN + ct * 64 + part * 8);
            *(LAS u32x4*)(T + i * HYP_LD + part * 8) = v; }
        __syncthreads();
        {   const int cl = tid & 63, tc = tid >> 6, c = ct * 64 + cl;
            const float w0 = cw[c], w1 = cw[IN_A + c], w2 = cw[2 * IN_A + c], bb = cb[c];
            float x[10];
#pragma unroll
            for (int i = 0; i < 10; ++i) x[i] = bf2f(T[(tc * 8 + i) * HYP_LD + cl]);
            float y[8];
#pragma unroll
            for (int i = 0; i < 8; ++i) y[i] = w0 * x[i] + w1 * x[i + 1] + w2 * x[i + 2] + bb;
            u32x4 o; o.x = pk2(y[0], y[1]); o.y = pk2(y[2], y[3]); o.z = pk2(y[4], y[5]); o.w = pk2(y[6], y[7]);
            *(u32x4*)(dst + (size_t)(c >> 8) * which_stride + ((size_t)(c & 255) * NB + b) * L + t0 + tc * 8) = o; }
    }
    __syncthreads();
}
constexpr int SGU_LD = 136;
__device__ __forceinline__ void sgu_phase(const Params& p, int l, int nitems, LAS unsigned char* lds, int vcu, int G) {
    typedef float f32x16 __attribute__((ext_vector_type(16)));
    int tid_o = threadIdx.x; asm volatile("" : "+v"(tid_o));
    const int tid = tid_o, lane = tid & 63, wave = __builtin_amdgcn_readfirstlane(tid >> 6);
    LAS bf16_t* VT = (LAS bf16_t*)lds;
    const bf16_t* P = (const bf16_t*)(p.ws + WS_A);
    bf16_t* MIX = (bf16_t*)(p.ws + WS_MIX);
    const int r = lane & 31, h = lane >> 5, g = wave >> 1, dt = wave & 1;
    for (int item = vcu; item < nitems; item += G) {
        const size_t row0 = item < 128 ? (size_t)item * 128 : (size_t)MLAT + (size_t)(item - 128) * 128;
        __syncthreads();
        {   const int q = tid >> 2, dq = tid & 3;
#pragma unroll
            for (int gg = 0; gg < 4; ++gg) {
                const bf16_t* src = P + (row0 + q) * D_IN + IN_A + D_SG + gg * 64 + dq * 16;
                const u32x4 w0 = *(const u32x4*)src, w1 = *(const u32x4*)(src + 8);
                float x[16];
                x[0] = bflo(w0.x); x[1] = bfhi(w0.x); x[2] = bflo(w0.y); x[3] = bfhi(w0.y); x[4] = bflo(w0.z); x[5] = bfhi(w0.z); x[6] = bflo(w0.w); x[7] = bfhi(w0.w);
                x[8] = bflo(w1.x); x[9] = bfhi(w1.x); x[10] = bflo(w1.y); x[11] = bfhi(w1.y); x[12] = bflo(w1.z); x[13] = bfhi(w1.z); x[14] = bflo(w1.w); x[15] = bfhi(w1.w);
                float sm = 0.f;
#pragma unroll
                for (int i = 0; i < 16; ++i) { x[i] = gelu_tanh(x[i]); sm += x[i]; }
                sm += __shfl_xor(sm, 1); sm += __shfl_xor(sm, 2);
                const float mu = sm * (1.f / 64.f); float s2 = 0.f;
#pragma unroll
                for (int i = 0; i < 16; ++i) { x[i] -= mu; s2 += x[i] * x[i]; }
                s2 += __shfl_xor(s2, 1); s2 += __shfl_xor(s2, 2);
                const float rstd = rsqrtf(s2 * (1.f / 64.f) + EPS);
                const float* lg = p.in[17] + ((size_t)l * 4 + gg) * 64 + dq * 16; const float* lb = p.in[18] + ((size_t)l * 4 + gg) * 64 + dq * 16;
#pragma unroll
                for (int i = 0; i < 16; ++i) VT[(gg * 64 + dq * 16 + i) * SGU_LD + q] = (bf16_t)f2bf(x[i] * rstd * lg[i] + lb[i]);
            }
        }
        __syncthreads();
        bf16x8 bfr[8];
        { LAS const bf16_t* bp = VT + (g * 64 + 32 * dt + r) * SGU_LD + 8 * h;
#pragma unroll
          for (int ks = 0; ks < 8; ++ks) bfr[ks] = *(LAS const bf16x8*)(bp + 16 * ks); }
        const int d = 32 * dt + r;
#pragma unroll 1
        for (int pt = 0; pt < 4; ++pt) {
            const float* Wp = p.in[19] + (((size_t)l * 4 + g) * 128 + 32 * pt + r) * 128 + 8 * h;
            f32x16 acc;
#pragma unroll
            for (int i = 0; i < 16; ++i) acc[i] = 0.f;
#pragma unroll
            for (int ks = 0; ks < 8; ++ks) { const f32x4 a0 = *(const f32x4*)(Wp + 16 * ks), a1 = *(const f32x4*)(Wp + 16 * ks + 4);
                u32x4 w; w.x = cvt_pk_bf16(a0.x, a0.y); w.y = cvt_pk_bf16(a0.z, a0.w); w.z = cvt_pk_bf16(a1.x, a1.y); w.w = cvt_pk_bf16(a1.z, a1.w);
                acc = __builtin_amdgcn_mfma_f32_32x32x16_bf16(__builtin_bit_cast(bf16x8, w), bfr[ks], acc, 0, 0, 0); }
            const float* bsp = p.in[20] + ((size_t)l * 4 + g) * 128 + 32 * pt + 4 * h;
            const bf16_t* up = P + (row0 + 32 * pt + 4 * h) * D_IN + IN_A + g * 64 + d;
            bf16_t* op = MIX + (row0 + 32 * pt + 4 * h) * DM + D_HY + g * 64 + d;
#pragma unroll
            for (int i = 0; i < 16; ++i) { const int pr = (i & 3) + 8 * (i >> 2);
                const float u = gelu_tanh(bf2f(up[(size_t)pr * D_IN]));
                op[(size_t)pr * DM] = (bf16_t)f2bf(u * (acc[i] + bsp[pr])); }
        }
    }
    __syncthreads();
}

namespace att {
typedef short s16x4 __attribute__((ext_vector_type(4)));
typedef float f32x16 __attribute__((ext_vector_type(16)));
constexpr int KVBLK = 64, SHM_T = 16384;
constexpr int OFF_V = 0, OFF_K = 2 * SHM_T, OFF_STAGE = 0, STAGE_LD = 132, OFF_SCR = 69632;
#define KSWZ(row, colB) ((row) * 256 + ((colB) ^ (((row) & 7) << 4)))
#define SBAR() __builtin_amdgcn_sched_barrier(0)
__device__ __forceinline__ int crow(int r, int hi) { return (r & 3) + 8 * (r >> 2) + 4 * hi; }
__device__ __forceinline__ int v_st(int k, int c) { const int kk = (k & ~0xC) | ((k & 4) << 1) | ((k & 8) >> 1); return ((kk >> 3) * 4 + (c >> 5)) * 512 + ((kk & 7) * 32 + (c & 31)) * 2; }
__device__ __forceinline__ int v_rd_base(int lane) { return ((lane & 3) << 3) | (((lane >> 2) & 3) << 6) | (((lane >> 4) & 1) << 5) | (((lane >> 5) & 1) << 8); }
constexpr int v_rd_off(int d0, int ks, int half) { return d0 * 512 + ks * 4096 + half * 2048; }
template <int OFF> __device__ __forceinline__ s16x4 tr_read(int vb) {
    s16x4 r; asm volatile("ds_read_b64_tr_b16 %0, %1 offset:%2" : "=&v"(r) : "v"(vb), "i"(OFF) : "memory"); return r; }
template <int D0> __device__ __forceinline__ void pv_one(f32x16& od, int vb, bf16x8 pa0, bf16x8 pa1, bf16x8 pa2, bf16x8 pa3) {
    const s16x4 l0 = tr_read<v_rd_off(D0, 0, 0)>(vb), h0 = tr_read<v_rd_off(D0, 0, 1)>(vb), l1 = tr_read<v_rd_off(D0, 1, 0)>(vb), h1 = tr_read<v_rd_off(D0, 1, 1)>(vb);
    const s16x4 l2 = tr_read<v_rd_off(D0, 2, 0)>(vb), h2 = tr_read<v_rd_off(D0, 2, 1)>(vb), l3 = tr_read<v_rd_off(D0, 3, 0)>(vb), h3 = tr_read<v_rd_off(D0, 3, 1)>(vb);
    asm volatile("s_waitcnt lgkmcnt(0)" ::: "memory"); SBAR();
#define PK(L, H) (bf16x8){L[0], L[1], L[2], L[3], H[0], H[1], H[2], H[3]}
    od = __builtin_amdgcn_mfma_f32_32x32x16_bf16(pa0, PK(l0, h0), od, 0, 0, 0);
    od = __builtin_amdgcn_mfma_f32_32x32x16_bf16(pa1, PK(l1, h1), od, 0, 0, 0);
    od = __builtin_amdgcn_mfma_f32_32x32x16_bf16(pa2, PK(l2, h2), od, 0, 0, 0);
    od = __builtin_amdgcn_mfma_f32_32x32x16_bf16(pa3, PK(l3, h3), od, 0, 0, 0);
#undef PK
}
__device__ __forceinline__ void tile_compute(f32x16 (&o)[4], float& l_reg, const bf16x8 (&qr)[4], const f32x16& negm, LAS const unsigned char* Kt, int vb, int kcb, int r32) {
    f32x16 p0, p1;
#pragma unroll
    for (int d0 = 0; d0 < 4; ++d0) { const int cb = kcb + d0 * 32;
        const bf16x8 b0 = *(LAS const bf16x8*)(Kt + KSWZ(r32, cb)); const bf16x8 b1 = *(LAS const bf16x8*)(Kt + KSWZ(32 + r32, cb));
        if (d0 == 0) { p0 = __builtin_amdgcn_mfma_f32_32x32x16_bf16(b0, qr[0], negm, 0, 0, 0); p1 = __builtin_amdgcn_mfma_f32_32x32x16_bf16(b1, qr[0], negm, 0, 0, 0); }
        else { p0 = __builtin_amdgcn_mfma_f32_32x32x16_bf16(b0, qr[d0], p0, 0, 0, 0); p1 = __builtin_amdgcn_mfma_f32_32x32x16_bf16(b1, qr[d0], p1, 0, 0, 0); } }
#pragma unroll
    for (int r = 0; r < 16; ++r) { p0[r] = __builtin_amdgcn_exp2f(p0[r]); p1[r] = __builtin_amdgcn_exp2f(p1[r]); }
    float ps = 0.f;
#pragma unroll
    for (int r = 0; r < 16; ++r) ps += p0[r] + p1[r];
    l_reg += ps;
    bf16x8 pa0, pa1, pa2, pa3;
#define PK4(P, BASE, OUT) do { unsigned a0 = cvt_pk_bf16(P[BASE + 0], P[BASE + 1]), a1 = cvt_pk_bf16(P[BASE + 2], P[BASE + 3]);   \
    unsigned b0_ = cvt_pk_bf16(P[BASE + 4], P[BASE + 5]), b1_ = cvt_pk_bf16(P[BASE + 6], P[BASE + 7]);                              \
    auto r0 = __builtin_amdgcn_permlane32_swap(a0, b0_, false, false); auto r1 = __builtin_amdgcn_permlane32_swap(a1, b1_, false, false); \
    u32x4 w = {r0[0], r1[0], r0[1], r1[1]}; OUT = __builtin_bit_cast(bf16x8, w); } while (0)
    PK4(p0, 0, pa0); PK4(p0, 8, pa1); PK4(p1, 0, pa2); PK4(p1, 8, pa3);
#undef PK4
    pv_one<0>(o[0], vb, pa0, pa1, pa2, pa3); pv_one<1>(o[1], vb, pa0, pa1, pa2, pa3); pv_one<2>(o[2], vb, pa0, pa1, pa2, pa3); pv_one<3>(o[3], vb, pa0, pa1, pa2, pa3);
}
struct Stg { u32x4 vs0, vs1, ks0, ks1; };
__device__ __forceinline__ void attn_unit(const Params& p, int l, int b, int h, int q0, bool ctxu, LAS unsigned char* lds, float lam, float lam_init, float M2) {
    int tid_o = threadIdx.x; asm volatile("" : "+v"(tid_o));
    const int tid = tid_o, lane = tid & 63, r32 = lane & 31, hi = lane >> 5;
    const int wid = __builtin_amdgcn_readfirstlane(tid >> 6), comp = wid >> 2, wq = wid & 3;
    const bf16_t* P = (const bf16_t*)(p.ws + WS_A);
    const size_t lat0 = (size_t)b * SEQ, ctx0 = (size_t)MLAT + (size_t)b * CTXL;
    const size_t qrow0 = (ctxu ? ctx0 : lat0) + q0 + wq * 32;
    const int NT = ctxu ? CTXL / KVBLK : (SEQ + CTXL) / KVBLK;
    LAS unsigned char* V_lds = lds + OFF_V; LAS unsigned char* K_lds = lds + OFF_K;
    LAS float* scr = (LAS float*)(lds + OFF_SCR) + wid * 64;
    bf16x8 qr[4];
    { const bf16_t* Qw = P + (qrow0 + r32) * D_IN + COL_Q + h * 128 + comp * 64 + hi * 8;
#pragma unroll
      for (int d0 = 0; d0 < 4; ++d0) qr[d0] = *(const bf16x8*)(Qw + d0 * 16); }
    f32x16 negm;
#pragma unroll
    for (int r = 0; r < 16; ++r) negm[r] = -M2;
    f32x16 o[4];
#pragma unroll
    for (int d = 0; d < 4; ++d)
#pragma unroll
        for (int r = 0; r < 16; ++r) o[d][r] = 0.f;
    float l_reg = 0.f;
    const int sr = tid >> 4, sc = (tid & 15) * 8;
    const int vst0 = v_st(sr, sc), vst1 = v_st(32 + sr, sc), kst0 = KSWZ(sr, sc * 2), kst1 = KSWZ(32 + sr, sc * 2);
    const int vb0 = (int)(unsigned)(uintptr_t)V_lds + v_rd_base(lane);
    const int kcb = (comp * 64 + hi * 8) * 2;
    const bf16_t* Kg = P + COL_K + h * 128 + sc; const bf16_t* Vg = P + COL_V + h * 128 + sc;
#define KROW(t_, rr) ((ctxu || (t_) >= SEQ / KVBLK) ? (ctx0 + (size_t)((t_) - (ctxu ? 0 : SEQ / KVBLK)) * KVBLK + (rr)) : (lat0 + (size_t)(t_) * KVBLK + (rr)))
#define SLOAD(S, t_) do { const size_t ra = KROW(t_, sr) * D_IN, rb = KROW(t_, 32 + sr) * D_IN; \
        S.vs0 = *(const u32x4*)(Vg + ra); S.vs1 = *(const u32x4*)(Vg + rb); S.ks0 = *(const u32x4*)(Kg + ra); S.ks1 = *(const u32x4*)(Kg + rb); } while (0)
#define SWRITE(bf, S) do { *(LAS u32x4*)(V_lds + (bf) * SHM_T + vst0) = S.vs0; *(LAS u32x4*)(V_lds + (bf) * SHM_T + vst1) = S.vs1; \
        *(LAS u32x4*)(K_lds + (bf) * SHM_T + kst0) = S.ks0; *(LAS u32x4*)(K_lds + (bf) * SHM_T + kst1) = S.ks1; } while (0)
    Stg s0, s1;
    SLOAD(s0, 0); SWRITE(0, s0);
    SLOAD(s0, 1); SLOAD(s1, 2);
    __syncthreads();
    for (int j = 0; j < NT; j += 2) {
        SWRITE(1, s0); if (j + 3 < NT) SLOAD(s0, j + 3);
        tile_compute(o, l_reg, qr, negm, K_lds, vb0, kcb, r32);
        __syncthreads();
        if (j + 2 < NT) { SWRITE(0, s1); if (j + 4 < NT) SLOAD(s1, j + 4); }
        tile_compute(o, l_reg, qr, negm, K_lds + SHM_T, vb0 + SHM_T, kcb, r32);
        __syncthreads();
    }
#undef SLOAD
#undef SWRITE
#undef KROW
    const float lt = l_reg + __shfl_xor(l_reg, 32);
    const float rl = (comp == 0 ? 1.f : lam) / lt;
    if (hi == 0) scr[r32] = rl;
    asm volatile("s_waitcnt lgkmcnt(0)" ::: "memory");
    float rli[16];
#pragma unroll
    for (int r = 0; r < 16; ++r) rli[r] = scr[crow(r, hi)];
    LAS float* stage = (LAS float*)(lds + OFF_STAGE) + wq * 32 * STAGE_LD;
    if (comp == 1) {
#pragma unroll
        for (int d0 = 0; d0 < 4; ++d0)
#pragma unroll
            for (int r = 0; r < 16; ++r) stage[crow(r, hi) * STAGE_LD + 32 * d0 + r32] = o[d0][r] * rli[r];
    }
    __syncthreads();
    if (comp == 0) {
#pragma unroll
        for (int d0 = 0; d0 < 4; ++d0)
#pragma unroll
            for (int r = 0; r < 16; ++r) { const int idx = crow(r, hi) * STAGE_LD + 32 * d0 + r32; stage[idx] = o[d0][r] * rli[r] - stage[idx]; }
        asm volatile("s_waitcnt lgkmcnt(0)" ::: "memory");
        const int row = lane >> 1, half = lane & 1;
        f32x4 v[16]; float ss = 0.f;
#pragma unroll
        for (int i = 0; i < 16; ++i) { v[i] = *(LAS const f32x4*)(stage + row * STAGE_LD + half * 64 + 4 * i); ss += (v[i].x * v[i].x + v[i].y * v[i].y) + (v[i].z * v[i].z + v[i].w * v[i].w); }
        ss += __shfl_xor(ss, 1);
        const float rstd = rsqrtf(ss * (1.f / VD) + EPS) * (1.f - lam_init);
        const float* gs = p.in[27] + (size_t)l * VD + half * 64;
        bf16_t* dst = (bf16_t*)(p.ws + WS_MIX) + (qrow0 + row) * DM + 512 + h * 128 + half * 64;
#pragma unroll
        for (int i = 0; i < 8; ++i) { const f32x4 g0 = *(const f32x4*)(gs + 8 * i), g1 = *(const f32x4*)(gs + 8 * i + 4); const f32x4 a = v[2 * i] * rstd * g0, c = v[2 * i + 1] * rstd * g1;
            u32x4 w; w.x = cvt_pk_bf16(a.x, a.y); w.y = cvt_pk_bf16(a.z, a.w); w.z = cvt_pk_bf16(c.x, c.y); w.w = cvt_pk_bf16(c.z, c.w);
            *(u32x4*)(dst + 8 * i) = w; }
    }
    __syncthreads();
}
__device__ __forceinline__ void attn_scalars(const Params& p, int l, int lane, float& lam, float& lam_init, float& M2) {
    float s1 = p.in[23][l * QKD + lane] * p.in[24][l * QKD + lane], s2 = p.in[25][l * QKD + lane] * p.in[26][l * QKD + lane];
    float gq = fabsf(p.in[21][l * QKD + lane]), gk = fabsf(p.in[22][l * QKD + lane]);
#pragma unroll
    for (int o = 1; o < 64; o <<= 1) { s1 += __shfl_xor(s1, o); s2 += __shfl_xor(s2, o); gq = fmaxf(gq, __shfl_xor(gq, o)); gk = fmaxf(gk, __shfl_xor(gk, o)); }
    lam_init = 0.8f - 0.6f * expf(-0.3f * (float)l);
    lam = expf(s1) - expf(s2) + lam_init;
    M2 = 8.f * gq * gk * LOG2E;
}
__device__ __forceinline__ void attn_phase(const Params& p, int l, LAS unsigned char* lds, int vcu, int G, bool with_ctx) {
    float lam, lam_init, M2; attn_scalars(p, l, threadIdx.x & 63, lam, lam_init, M2);
    const int nunits = 512 + (with_ctx ? 64 : 0);
    for (int u = vcu; u < nunits; u += G) {
        if (u < 512) attn_unit(p, l, u >> 6, (u >> 4) & 3, (u & 15) * 128, false, lds, lam, lam_init, M2);
        else { const int v = u - 512; attn_unit(p, l, v >> 3, (v >> 1) & 3, (v & 1) * 128, true, lds, lam, lam_init, M2); }
    }
}
#undef KSWZ
#undef SBAR
}

namespace hyc {
typedef float f32x16 __attribute__((ext_vector_type(16)));
constexpr int UOFF = 65536, UBLK = 640, ROFF = UOFF + 70 * UBLK;
__device__ __forceinline__ int crow(int r, int hi) { return (r & 3) + 8 * (r >> 2) + 4 * hi; }
__device__ __forceinline__ void conv_unit(const Params& p, int l, int order, int c, bool ctxu, LAS unsigned char* lds) {
    int tid_o = threadIdx.x; asm volatile("" : "+v"(tid_o));
    const int tid = tid_o, lane = tid & 63, wave = __builtin_amdgcn_readfirstlane(tid >> 6);
    const int L = ctxu ? CTXL : SEQ, nblk = L >> 5, FLEN = 2 * L;
    const bf16_t* R = ctxu ? (const bf16_t*)(p.ws + WS_FILTC) + ((size_t)order * D_HY + c) * FLEN
                           : (const bf16_t*)(p.ws + WS_FILT) + (((size_t)l * 2 + order) * D_HY + c) * FLEN;
    bf16_t* HY = ctxu ? (bf16_t*)(p.ws + WS_HYTC) : (bf16_t*)(p.ws + WS_HYT);
    const size_t wst = ctxu ? HYT_CTX_ELEMS : HYT_LAT_ELEMS;
    const size_t coff = (size_t)c * NB * L;
    const bf16_t* Uin = HY + (order == 0 ? 0 : 3) * wst + coff;
    const bf16_t* Xg = HY + (order == 0 ? 1 : 2) * wst + coff;
    for (int i = tid; i < FLEN / 8; i += 512) *(LAS u32x4*)(lds + ROFF + 16 * i) = *(const u32x4*)(R + 8 * i);
    if (tid < 8) *(LAS unsigned*)(lds + ROFF + FLEN * 2 + 4 * tid) = 0u;
    for (int ch = tid; ch < L; ch += 512) { const int b = ch / (L >> 3), s = (ch % (L >> 3)) * 8;
        const u32x4 v = *(const u32x4*)(Uin + (size_t)b * L + s);
        *(LAS u32x4*)(lds + UOFF + ((s >> 5) + 3) * UBLK + ((s >> 4) & 1) * 256 + ((s >> 3) & 1) * 128 + b * 16) = v; }
    if (tid < 240) { const int blk = tid / 40, w = tid % 40; const int J = blk < 3 ? blk - 3 : nblk + (blk - 3);
        *(LAS u32x4*)(lds + UOFF + (J + 3) * UBLK + w * 16) = (u32x4){0u, 0u, 0u, 0u}; }
    __syncthreads();
    for (int e = tid; e < FLEN; e += 512) {
        LAS const unsigned* r32p = (LAS const unsigned*)(lds + ROFF) + (e >> 1);
        const unsigned d0 = r32p[0], d1 = r32p[1], d2 = r32p[2], d3 = r32p[3], d4 = r32p[4];
        u32x4 w;
        if (e & 1) { w.x = __builtin_amdgcn_alignbit(d1, d0, 16); w.y = __builtin_amdgcn_alignbit(d2, d1, 16); w.z = __builtin_amdgcn_alignbit(d3, d2, 16); w.w = __builtin_amdgcn_alignbit(d4, d3, 16); }
        else { w.x = d0; w.y = d1; w.z = d2; w.w = d3; }
        *(LAS u32x4*)(lds + 16 * e) = w; }
    __syncthreads();
    const int r = lane & 31, h = lane >> 5, bb = lane & 7, q = (lane >> 3) & 3;
    const float bias = p.in[16][((size_t)l * 2 + order) * D_HY + c];
    for (int g = wave; g < (nblk >> 2); g += 8) {
        const int I0 = 4 * g;
        f32x16 acc;
#pragma unroll
        for (int i = 0; i < 16; ++i) acc[i] = 0.f;
        const int dlo = I0 - (nblk - 1), dhi = I0 + 3;
        LAS const unsigned char* ap = lds + 16 * ((L - 1) - 32 * dlo - r + 8 * h);
        LAS const unsigned char* bp = lds + UOFF + (I0 + q - dlo + 3) * UBLK + h * 128 + bb * 16;
        for (int d = dlo; d <= dhi; ++d) {
            const bf16x8 a0 = *(LAS const bf16x8*)(ap), a1 = *(LAS const bf16x8*)(ap + 256);
            const bf16x8 b0 = *(LAS const bf16x8*)(bp), b1 = *(LAS const bf16x8*)(bp + 256);
            acc = __builtin_amdgcn_mfma_f32_32x32x16_bf16(a0, b0, acc, 0, 0, 0);
            acc = __builtin_amdgcn_mfma_f32_32x32x16_bf16(a1, b1, acc, 0, 0, 0);
            ap -= 512; bp -= UBLK;
        }
        const int tb = 32 * (I0 + q) + 4 * h;
        const size_t boff = (size_t)bb * L;
#pragma unroll
        for (int gq = 0; gq < 4; ++gq) {
            const int t = tb + 8 * gq;
            const uint2 xu = *(const uint2*)(Xg + boff + t), uu = *(const uint2*)(Uin + boff + t);
            float o[4];
            o[0] = bflo(xu.x) * (acc[4 * gq + 0] + bias * bflo(uu.x)); o[1] = bfhi(xu.x) * (acc[4 * gq + 1] + bias * bfhi(uu.x));
            o[2] = bflo(xu.y) * (acc[4 * gq + 2] + bias * bflo(uu.y)); o[3] = bfhi(xu.y) * (acc[4 * gq + 3] + bias * bfhi(uu.y));
            if (order == 0) { uint2 w; w.x = cvt_pk_bf16(o[0], o[1]); w.y = cvt_pk_bf16(o[2], o[3]); *(uint2*)(HY + 3 * wst + coff + boff + t) = w; }
            else { bf16_t* mx = (bf16_t*)(p.ws + WS_MIX) + ((ctxu ? (size_t)MLAT + (size_t)bb * CTXL : (size_t)bb * SEQ) + t) * DM + c;
#pragma unroll
                   for (int j = 0; j < 4; ++j) mx[(size_t)j * DM] = (bf16_t)f2bf(o[j]); }
        }
    }
    __syncthreads();
}
__device__ __forceinline__ void conv_phase(const Params& p, int l, int order, LAS unsigned char* lds, int vcu, int G, bool with_ctx) {
    for (int c = vcu; c < D_HY; c += G) { conv_unit(p, l, order, c, false, lds); if (with_ctx) conv_unit(p, l, order, c, true, lds); }
}
}

constexpr int RING_OFF = 0, RING_BYTES = 131072;
constexpr int LDSCTL_OFF = RING_BYTES, MISC_OFF = LDSCTL_OFF + 320;
constexpr int LDS_BYTES = 147456;
constexpr int CW_BAR = 131072;
constexpr size_t WS_RAW = WS_B + 36 * MiB;

struct MkArgs { Params p; int ph_lo, ph_hi, li, sub; };

enum Phase { PH_PRO_A = 0, PH_PRO_B = 1, PH_N0 = 2, PH_L0 = 3, PHL_GEMM_IN = 0, PHL_PREP = 1, PHL_MIX1 = 2, PHL_MIX2 = 3, PHL_GEMM_OUT = 4, PHL_GEMM_UP = 5, PHL_FIXUP = 6, PHL_GEMM_DOWN = 7, PHL_N = 8, PH_TOTAL = 3 + 2 * 8 };

__device__ __forceinline__ void fixup_phase(const Params& p, int l, int nchunks, int wid_g, int nw_g, int lane) {
    const float* RAW = (const float*)(p.ws + WS_RAW); bf16_t* G = (bf16_t*)(p.ws + WS_A);
    const float* cw = p.in[31] + (size_t)l * 3 * D_FF2; const float* cb = p.in[32] + (size_t)l * D_FF2;
    const int nitems = nchunks * 2 * 11;
    for (int it = wid_g; it < nitems; it += nw_g) {
        const int slab = it % 11, rw = (it / 11) & 1, q = it / 22;
        const int row = q * 64 + (rw ? 63 : 0);
        const int L = row < MLAT ? SEQ : CTXL, t = row < MLAT ? row % SEQ : (row - MLAT) % CTXL;
        const int o = slab * 256 + lane * 4;
        const int rg = 256 * (o / 128) + (o % 128);
        const float* rp; const float* rc; const float* rn; bool hp, hn;
        if (!rw) { hp = t > 0; rp = RAW + ((size_t)(q - 1) * 4 + 3) * D_FF2; rc = RAW + ((size_t)q * 4 + 0) * D_FF2; rn = RAW + ((size_t)q * 4 + 1) * D_FF2; hn = true; }
        else { hp = true; rp = RAW + ((size_t)q * 4 + 2) * D_FF2; rc = RAW + ((size_t)q * 4 + 3) * D_FF2; hn = t < L - 1; rn = RAW + ((size_t)(q + 1) * 4 + 0) * D_FF2; }
        const f32x4 z = {0.f, 0.f, 0.f, 0.f};
        const f32x4 gp = hp ? *(const f32x4*)(rp + rg) : z, vp = hp ? *(const f32x4*)(rp + rg + 128) : z;
        const f32x4 gc = *(const f32x4*)(rc + rg), vc = *(const f32x4*)(rc + rg + 128);
        const f32x4 gn = hn ? *(const f32x4*)(rn + rg) : z, vn = hn ? *(const f32x4*)(rn + rg + 128) : z;
        const f32x4 cg = *(const f32x4*)(cw + o) * gp + *(const f32x4*)(cw + D_FF2 + o) * gc + *(const f32x4*)(cw + 2 * D_FF2 + o) * gn + *(const f32x4*)(cb + o);
        const f32x4 cv = *(const f32x4*)(cw + D_FF + o) * vp + *(const f32x4*)(cw + D_FF2 + D_FF + o) * vc + *(const f32x4*)(cw + 2 * D_FF2 + D_FF + o) * vn + *(const f32x4*)(cb + D_FF + o);
        float oo[4];
#pragma unroll
        for (int j = 0; j < 4; ++j) oo[j] = cg[j] * __builtin_amdgcn_rcpf(1.f + __expf(-cg[j])) * cv[j];
        uint2 w; w.x = cvt_pk_bf16(oo[0], oo[1]); w.y = cvt_pk_bf16(oo[2], oo[3]);
        *(uint2*)(G + (size_t)row * D_FF + o) = w;
    }
}

__global__ void __launch_bounds__(NWAVES * 64, 2) mk_fwd(MkArgs a) {
    extern __shared__ __attribute__((aligned(16))) unsigned char lds_raw[];
    LAS unsigned char* lds = (LAS unsigned char*)lds_raw;
    const Params& p = a.p;
    const int tid = threadIdx.x, lane = tid & 63, wave = __builtin_amdgcn_readfirstlane(tid >> 6);
    const int G = gridDim.x; const int bx = blockIdx.x; const int vcu = (G % 8 == 0) ? (bx % 8) * (G / 8) + bx / 8 : bx;
    volatile LAS unsigned* MISC = (volatile LAS unsigned*)(lds + MISC_OFF);
    for (int u = tid; u < (LDS_BYTES - LDSCTL_OFF) / 4; u += NWAVES * 64) ((LAS unsigned*)(lds + LDSCTL_OFF))[u] = 0u;
    __syncthreads();
    unsigned* ctl = (unsigned*)(p.ws + WS_CTL);
    XcdBarrier bar; bar.bar = ctl + CW_BAR + a.li * XCD_BAR_WORDS; bar.x = 0; bar.st = nullptr;
    const bool multi = (a.ph_hi - a.ph_lo) > 1;
    if (multi) bar = xcd_barrier_post(ctl + CW_BAR + a.li * XCD_BAR_WORDS, MISC + 8);
    const int lo = a.ph_lo, hi = a.ph_hi;
#define IN(k) (lo <= (k) && (k) < hi)
#define SEAM(k) do { if (IN(k) && IN((k) + 1)) xcd_barrier(bar); } while (0)
    bf16_t* HBF = (bf16_t*)(p.ws + WS_HBF); bf16_t* PA = (bf16_t*)(p.ws + WS_A); bf16_t* MIX = (bf16_t*)(p.ws + WS_MIX);
    const float* MOD = (const float*)(p.ws + WS_MOD);
    const int sub = a.sub; const bool probe = a.li != 0;
    if (IN(PH_PRO_A)) { if (sub & 1) wconv_phase(p, lds, vcu, G); if (sub & 2) mod_phase(p, lds, vcu, G); if (sub & 4) filters_phase(p, lds, vcu, G); }
    SEAM(PH_PRO_A);
    if (IN(PH_PRO_B)) modred_phase(p, vcu, G);
    SEAM(PH_PRO_B);
    if (IN(PH_N0)) { if (sub & 1) norm0_phase(p, vcu, G); if (sub & 2) shw_phase(p, lds, vcu, G); }
    SEAM(PH_N0);
    unsigned long long* SS = (unsigned long long*)(p.ws + WS_SS); const float* SHW = (const float*)(p.ws + WS_SHW);
    for (int l = 0; l < DEPTH; ++l) {
        const int pb = PH_L0 + l * PHL_N; const bool last = (l == DEPTH - 1);
        const int nMt = last ? MLAT / BM : MTOT / BM;
        if (IN(pb + PHL_GEMM_IN)) {
            Gemm g{HBF, (const bf16_t*)(p.ws + WS_WIN) + (size_t)l * D_IN * DM, MTOT, D_IN, DM};
            RectOrder S; S.init(MLAT / BM, D_IN / BM, MCTX / BM, last ? (D_IN - COL_Q) / BM : D_IN / BM, MLAT / BM, last ? COL_Q / BM : 0, G, bx);
            EpiP E{PA, D_IN, SS + (size_t)(2 * l) * MTOT, SHW + (size_t)(2 * l) * 9 * D_FF2};
            gemm_phase<EpiP, RectOrder, true, true>(lds + RING_OFF, g, S, E);
        }
        SEAM(pb + PHL_GEMM_IN);
        if (IN(pb + PHL_PREP)) { if (sub & 1) prep_qk_phase(p, l, MTOT, vcu, G); if (sub & 2) prep_hy_phase(p, l, !last, lds, vcu, G); if (sub & 4) sgu_phase(p, l, last ? 128 : 144, lds, vcu, G); }
        SEAM(pb + PHL_PREP);
        if (IN(pb + PHL_MIX1)) { if (sub & 1) att::attn_phase(p, l, lds + RING_OFF, vcu, G, !last); if (sub & 2) hyc::conv_phase(p, l, 0, lds + RING_OFF, vcu, G, !last); }
        SEAM(pb + PHL_MIX1);
        if (IN(pb + PHL_MIX2)) hyc::conv_phase(p, l, 1, lds + RING_OFF, vcu, G, !last);
        SEAM(pb + PHL_MIX2);
        if (IN(pb + PHL_GEMM_OUT)) {
            Gemm g{MIX, (const bf16_t*)(p.ws + WS_WOUT) + (size_t)l * DM * DM, MTOT, DM, DM};
            RectOrder S; S.init(nMt, DM / BM, 0, 0, 0, 0, G, bx);
            EpiRes E{l == 0 ? p.in[0] : (const float*)p.out, l == 0 ? p.in[2] : (const float*)(p.ws + WS_CS), probe ? (float*)(p.ws + WS_A + 32 * MiB) : p.out, (float*)(p.ws + WS_CS), MOD + (size_t)l * 9 * 6144 + 2048,
                     HBF, p.in[29] + (size_t)l * DM, MOD + (size_t)l * 9 * 6144 + 4096, SS + (size_t)(2 * l + 1) * MTOT};
            gemm_phase<EpiRes, RectOrder, true, true>(lds + RING_OFF, g, S, E);
        }
        SEAM(pb + PHL_GEMM_OUT);
        if (IN(pb + PHL_GEMM_UP)) {
            Gemm g{HBF, (const bf16_t*)(p.ws + WS_WUP) + (size_t)l * D_FF2 * DM, MTOT, D_FF2, DM};
            RectOrder S; S.init(nMt, D_FF2 / BM, 0, 0, 0, 0, G, bx);
            EpiCG E{PA, (float*)(p.ws + WS_RAW), p.in[31] + (size_t)l * 3 * D_FF2, p.in[32] + (size_t)l * D_FF2, SS + (size_t)(2 * l + 1) * MTOT, SHW + (size_t)(2 * l + 1) * 9 * D_FF2};
            gemm_phase<EpiCG, RectOrder, true, true>(lds + RING_OFF, g, S, E);
        }
        SEAM(pb + PHL_GEMM_UP);
        if (IN(pb + PHL_FIXUP)) fixup_phase(p, l, nMt * 4, vcu * NWAVES + wave, G * NWAVES, lane);
        SEAM(pb + PHL_FIXUP);
        if (IN(pb + PHL_GEMM_DOWN)) {
            Gemm g{PA, (const bf16_t*)(p.ws + WS_WDN) + (size_t)l * DM * D_FF, MTOT, DM, D_FF};
            RectOrder S; S.init(nMt, DM / BM, 0, 0, 0, 0, G, bx);
            EpiRes E{(const float*)p.out, (const float*)(p.ws + WS_CS), probe ? (float*)(p.ws + WS_A + 32 * MiB) : p.out, (float*)(p.ws + WS_CS), MOD + (size_t)l * 9 * 6144 + 5120,
                     last ? (bf16_t*)nullptr : HBF, p.in[6] + (size_t)(l + 1) * DM, MOD + (size_t)(l + 1) * 9 * 6144 + 1024, SS + (size_t)(2 * l + 2) * MTOT};
            gemm_phase<EpiRes, RectOrder, true, true>(lds + RING_OFF, g, S, E);
        }
        SEAM(pb + PHL_GEMM_DOWN);
    }
#undef IN
#undef SEAM
}
}

extern "C" void kernel_launch(void* const* d_in, const int* in_sizes, int n_in, void* d_out, int out_size, void* d_ws, size_t ws_size, hipStream_t stream) {
    static int ok = 0;
    if (ok == 0) {
        if (n_in != 34 || in_sizes[0] != MLAT * DM || out_size != MLAT * DM || ws_size < WS_END) {
            fprintf(stderr, "kernel_launch: unexpected shapes n_in %d in0 %d out %d ws %zu\n", n_in, n_in > 0 ? in_sizes[0] : -1, out_size, ws_size); ok = -1; return; }
        if (hipFuncSetAttribute((const void*)mk_fwd, hipFuncAttributeMaxDynamicSharedMemorySize, LDS_BYTES) != hipSuccess) { fprintf(stderr, "kernel_launch: LDS attribute failed\n"); ok = -1; return; }
        ok = 1;
    }
    if (ok < 0) return;
    (void)hipMemsetAsync((char*)d_ws + WS_CTL, 0, CTL_BYTES, stream);
    MkArgs a{};
    for (int i = 0; i < 34; ++i) a.p.in[i] = (const float*)d_in[i];
    a.p.out = (float*)d_out; a.p.ws = (unsigned char*)d_ws;
#if MK_PER_PHASE
    for (int ph = 0; ph < PH_TOTAL; ++ph) { a.ph_lo = ph; a.ph_hi = ph + 1; a.li = 0; a.sub = 0xff; hipLaunchKernelGGL(mk_fwd, dim3(256), dim3(NWAVES * 64), LDS_BYTES, stream, a); }
#else
    a.ph_lo = 0; a.ph_hi = PH_TOTAL; a.li = 0; a.sub = 0xff;
    hipLaunchKernelGGL(mk_fwd, dim3(256), dim3(NWAVES * 64), LDS_BYTES, stream, a);
#endif
#if PROBE_PH >= 0
    for (int r = 0; r < PROBE_REP; ++r) { a.ph_lo = PROBE_PH; a.ph_hi = PROBE_PH + 1; a.li = 1; a.sub = PROBE_SUB; hipLaunchKernelGGL(mk_fwd, dim3(256), dim3(NWAVES * 64), LDS_BYTES, stream, a); }
#endif
}
```

```cpp
#include <hip/hip_runtime.h>
#include <hip/hip_bf16.h>
#include <cstdint>
#include <cstdio>

#ifndef MK_PER_PHASE
#define MK_PER_PHASE 0
#endif
#ifndef PROBE_PH
#define PROBE_PH -1
#endif
#ifndef PROBE_REP
#define PROBE_REP 4
#endif
#ifndef PROBE_SUB
#define PROBE_SUB 0xff
#endif
namespace {
constexpr int DM = 1024, NB = 8, SEQ = 2048, DEPTH = 2, CTXL = 256;
constexpr int MLAT = NB * SEQ, MCTX = NB * CTXL, MTOT = MLAT + MCTX;
constexpr int D_HY = 256, D_SG = 256, NH = 4, QKD = 64, VD = 128;
constexpr int IN_A = 768, IN_B = 512, D_IN = 2816;
constexpr int COL_Q = 1280, COL_K = 1792, COL_V = 2304;
constexpr int D_FF = 2816, D_FF2 = 5632;
constexpr int HY_EMB = 33, HY_FFN = 64;
constexpr float EPS = 1e-6f;
constexpr float LOG2E = 1.4426950408889634f;
constexpr float QSCALE = 0.125f * LOG2E;
constexpr int FL = 2 * SEQ, FLC = 2 * CTXL;

constexpr size_t MiB = 1u << 20;
constexpr size_t WS_CTL = 0, CTL_BYTES = 2 * MiB;
constexpr size_t WS_MOD = 64 * 1024;
constexpr size_t WS_SS = 1 * MiB;
constexpr size_t WS_SHB = 2 * MiB + 896 * 1024;
constexpr size_t WS_SHW = 2 * MiB;
constexpr size_t WS_WIN = 3 * MiB, WS_WOUT = 14 * MiB, WS_WUP = 18 * MiB, WS_WDN = 40 * MiB;
constexpr size_t WS_CS = 51 * MiB;
constexpr size_t WS_FILT = 59 * MiB;
constexpr size_t WS_FILTC = 67 * MiB;
constexpr size_t WS_ROPE = 67 * MiB + 512 * 1024;
constexpr size_t WS_A = 68 * MiB;
constexpr size_t WS_B = 167 * MiB;
constexpr size_t WS_HBF = WS_B;
constexpr size_t WS_HYT = WS_B;
constexpr size_t HYT_LAT_ELEMS = (size_t)D_HY * NB * SEQ, HYT_CTX_ELEMS = (size_t)D_HY * NB * CTXL;
constexpr size_t WS_HYTC = WS_HYT + 4 * HYT_LAT_ELEMS * 2;
constexpr size_t WS_MIX = WS_B + 36 * MiB;
constexpr size_t WS_UCH = WS_B + 36 * MiB;
constexpr size_t WS_END = 239 * MiB;
constexpr float SS_SCALE = 16777216.f, SS_INV = 1.f / (16777216.f * 1024.f);

typedef unsigned short bf16_t;
typedef float f32x4 __attribute__((ext_vector_type(4)));
typedef short bf16x8 __attribute__((ext_vector_type(8)));
typedef unsigned u32x4 __attribute__((ext_vector_type(4)));

__device__ __forceinline__ unsigned f2bf(float f) { unsigned u = __builtin_bit_cast(unsigned, f); return (u + 0x7fffu + ((u >> 16) & 1u)) >> 16; }
__device__ __forceinline__ unsigned pk2(float lo, float hi) { return f2bf(lo) | (f2bf(hi) << 16); }
__device__ __forceinline__ float bf2f(unsigned short h) { return __builtin_bit_cast(float, (unsigned)h << 16); }
__device__ __forceinline__ float bflo(unsigned w) { return __builtin_bit_cast(float, w << 16); }
__device__ __forceinline__ float bfhi(unsigned w) { return __builtin_bit_cast(float, w & 0xffff0000u); }
__device__ __forceinline__ float silu_f(float x) { return x / (1.f + __expf(-x)); }
__device__ __forceinline__ float gelu_tanh(float x) { const float u2 = 1.5957691216057308f * (x + 0.044715f * x * x * x); return x * __builtin_amdgcn_rcpf(1.f + __expf(-u2)); }

struct Params {
    const float* in[34];
    float* out;
    unsigned char* ws;
};

__device__ __forceinline__ float modv(const Params& p, int l, int r, int idx) {
    const float* acc = (const float*)(p.ws + WS_MOD);
    return acc[((size_t)l * 9 + r) * 6144 + idx];
}

constexpr int NWAVES = 8;

#define PG8_LAS __attribute__((address_space(3)))
constexpr int BM = 256, BK = 64, HALF = 128, HTB = HALF * BK * 2  , STAGE_BYTES = 8 * HTB, NXCD = 8, WGM = 8;

__host__ __device__ __forceinline__ int lds_byte(int r, int c) { const int st = (r >> 4) * 2 + (c >> 5), rr = r & 15, cc = c & 31, ob = rr * 64 + cc * 2; return st * 1024 + (ob ^ (((ob >> 9) & 1) << 5)); }
__host__ __device__ __forceinline__ void stage_rc(int b, int& R, int& C) { const int st = b / 1024, sb = b % 1024, swz = sb ^ (((sb >> 9) & 1) << 5); R = (st >> 1) * 16 + swz / 64; C = (st & 1) * 32 + (swz % 64) / 2; }
__host__ __device__ __forceinline__ int perm32(int rho) { const int n = rho >> 4, i = rho & 15; return 8 * (i >> 2) + 4 * n + (i & 3); }

struct Unit { int pm, pn; };
struct Gemm { const bf16_t* A; const bf16_t* Bt; int M, N, K; };


struct RectOrder {
    int nM1, nN1, n1, nM2, nN2, n2, pm2off, pn2off, G, c;
    __device__ void init(int nM1_, int nN1_, int nM2_, int nN2_, int pm2off_, int pn2off_, int G_, int c_) {
        nM1 = nM1_; nN1 = nN1_; n1 = nM1_ * nN1_; nM2 = nM2_; nN2 = nN2_; n2 = nM2_ * nN2_; pm2off = pm2off_; pn2off = pn2off_; G = G_; c = c_; }
    __device__ __forceinline__ static void map(int wgid, int nM, int nN, int nwg, Unit& u) {
        { const int q = nwg / NXCD, r = nwg % NXCD, xcd = wgid % NXCD, off = wgid / NXCD; wgid = (xcd < r ? xcd * (q + 1) : r * (q + 1) + (xcd - r) * q) + off; }
        const int nig = WGM * nN, gid = wgid / nig, fm = gid * WGM, gsz = (nM - fm) < WGM ? (nM - fm) : WGM;
        u.pm = fm + ((wgid % nig) % gsz); u.pn = (wgid % nig) / gsz; }
    __device__ bool next(int i, Unit& u) const {
        long L = (long)i * G + c;
        if (L < n1) { map((int)L, nM1, nN1, n1, u); return true; }
        L -= n1; if (L < n2) { map((int)L, nM2, nN2, n2, u); u.pm += pm2off; u.pn += pn2off; return true; }
        return false; }
    __device__ __forceinline__ void a_ready(const Unit&) const {}
    __device__ __forceinline__ void done(const Unit&) const {}
};
__device__ __forceinline__ unsigned cvt_pk_bf16(float lo, float hi) { unsigned r; asm volatile("v_cvt_pk_bf16_f32 %0, %1, %2" : "=v"(r) : "v"(lo), "v"(hi)); return r; }

struct EpiP {
    static constexpr bool PERM = true, AFTER_DRAIN = false;
    bf16_t* O; int ldc; const unsigned long long* SSi; const float* shw;
    __device__ __forceinline__ void operator()(const f32x4 (&acc)[2][2][4][2], const Unit& u, int wr, int wc, int fr, int fq) const {
        const int row0 = u.pm * BM + wr * 64 + fr, col0 = u.pn * BM + wc * 32 + 8 * fq;
        const float* sp = shw + (size_t)(u.pm < MLAT / BM ? (u.pm >> 3) : 8) * D_FF2 + col0;
        f32x4 sv[2][2];
#pragma unroll
        for (int bj = 0; bj < 2; ++bj)
#pragma unroll
            for (int n = 0; n < 2; ++n) sv[bj][n] = *(const f32x4*)(sp + bj * HALF + 4 * n);
#pragma unroll
        for (int ai = 0; ai < 2; ++ai)
#pragma unroll
            for (int m = 0; m < 4; ++m) { const int row = row0 + ai * HALF + m * 16; bf16_t* rowp = O + (size_t)row * ldc + col0;
                const float rs = rsqrtf((float)SSi[row] * SS_INV + EPS);
#pragma unroll
                for (int bj = 0; bj < 2; ++bj) { const f32x4 v0 = acc[ai][bj][m][0] * rs + sv[bj][0], v1 = acc[ai][bj][m][1] * rs + sv[bj][1];
                    u32x4 w; w.x = cvt_pk_bf16(v0[0], v0[1]); w.y = cvt_pk_bf16(v0[2], v0[3]); w.z = cvt_pk_bf16(v1[0], v1[1]); w.w = cvt_pk_bf16(v1[2], v1[3]);
                    *(u32x4*)(rowp + bj * HALF) = w; } }
    }
};
struct EpiRes {
    static constexpr bool PERM = false, AFTER_DRAIN = false;
    const float* base_lat; const float* base_ctx; float* out_lat; float* out_ctx; const float* gate;
    bf16_t* Hn; const float* ng; const float* scp; unsigned long long* SSo;
    __device__ __forceinline__ void operator()(const f32x4 (&acc)[2][2][4][2], const Unit& u, int wr, int wc, int fr, int fq) const {
        const bool lat = u.pm < MLAT / BM;
        const float* base = lat ? base_lat : base_ctx; float* out = lat ? out_lat : out_ctx;
        const int rb = (lat ? u.pm * BM : u.pm * BM - MLAT) + wr * 64 + fr, col0 = u.pn * BM + wc * 32 + 4 * fq;
        const int mr = lat ? (u.pm >> 3) : 8;
        const float* gp = gate + (size_t)mr * 6144 + col0;
        f32x4 gv[2][2], gs[2][2];
#pragma unroll
        for (int bj = 0; bj < 2; ++bj)
#pragma unroll
            for (int n = 0; n < 2; ++n) { gv[bj][n] = *(const f32x4*)(gp + bj * HALF + n * 16);
                if (Hn) gs[bj][n] = *(const f32x4*)(ng + col0 + bj * HALF + n * 16) * (1.f + *(const f32x4*)(scp + (size_t)mr * 6144 + col0 + bj * HALF + n * 16)); }
#pragma unroll
        for (int ai = 0; ai < 2; ++ai)
#pragma unroll
            for (int m = 0; m < 4; ++m) { const size_t off = (size_t)(rb + ai * HALF + m * 16) * DM + col0;
                const size_t grow = (size_t)(u.pm * BM + wr * 64 + fr + ai * HALF + m * 16);
                float ss = 0.f;
#pragma unroll
                for (int bj = 0; bj < 2; ++bj)
#pragma unroll
                    for (int n = 0; n < 2; ++n) { const f32x4 bs = *(const f32x4*)(base + off + bj * HALF + n * 16);
                        const f32x4 o = bs + gv[bj][n] * acc[ai][bj][m][n];
                        *(f32x4*)(out + off + bj * HALF + n * 16) = o;
                        if (Hn) { ss += (o[0] * o[0] + o[1] * o[1]) + (o[2] * o[2] + o[3] * o[3]); const f32x4 a = o * gs[bj][n];
                            uint2 w; w.x = cvt_pk_bf16(a[0], a[1]); w.y = cvt_pk_bf16(a[2], a[3]); *(uint2*)(Hn + grow * DM + col0 + bj * HALF + n * 16) = w; } }
                if (Hn) { ss += __shfl_xor(ss, 16); ss += __shfl_xor(ss, 32);
                    if (fq == 0) atomicAdd(SSo + grow, (unsigned long long)(ss * SS_SCALE + 0.5f)); } }
    }
};
__device__ __forceinline__ float lane_prev16(float x, int) { return __builtin_bit_cast(float, __builtin_amdgcn_update_dpp(0, __builtin_bit_cast(int, x), 0x121, 0xf, 0xf, false)); }
__device__ __forceinline__ float lane_next16(float x, int) { return __builtin_bit_cast(float, __builtin_amdgcn_update_dpp(0, __builtin_bit_cast(int, x), 0x12f, 0xf, 0xf, false)); }
struct EpiCG {
    static constexpr bool PERM = true, AFTER_DRAIN = false;
    bf16_t* G; float* RAW; const float* cw; const float* cb; const unsigned long long* SSi; const float* shw;
    __device__ __forceinline__ void operator()(const f32x4 (&acc)[2][2][4][2], const Unit& u, int wr, int wc, int fr, int fq) const {
        const int lane = fq * 16 + fr;
        float rs[2][4];
#pragma unroll
        for (int ai = 0; ai < 2; ++ai)
#pragma unroll
            for (int m = 0; m < 4; ++m) rs[ai][m] = rsqrtf((float)SSi[u.pm * BM + ai * HALF + wr * 64 + m * 16 + fr] * SS_INV + EPS);
        const float* sp = shw + (size_t)(u.pm < MLAT / BM ? (u.pm >> 3) : 8) * D_FF2;
#pragma unroll
        for (int n = 0; n < 2; ++n) {
            const int oc = u.pn * HALF + wc * 32 + 8 * fq + 4 * n;
            const int rg = u.pn * BM + wc * 32 + 8 * fq + 4 * n;
            const f32x4 w0g = *(const f32x4*)(cw + oc), w1g = *(const f32x4*)(cw + D_FF2 + oc), w2g = *(const f32x4*)(cw + 2 * D_FF2 + oc), bg = *(const f32x4*)(cb + oc);
            const f32x4 w0v = *(const f32x4*)(cw + D_FF + oc), w1v = *(const f32x4*)(cw + D_FF2 + D_FF + oc), w2v = *(const f32x4*)(cw + 2 * D_FF2 + D_FF + oc), bv = *(const f32x4*)(cb + D_FF + oc);
            const f32x4 shg = *(const f32x4*)(sp + rg), shv = *(const f32x4*)(sp + rg + HALF);
#pragma unroll
            for (int ai = 0; ai < 2; ++ai) {
                const int rowc = u.pm * BM + ai * HALF + wr * 64;
                const int chunk = rowc >> 6;
                f32x4 sg[4], sv[4];
#pragma unroll
                for (int m = 0; m < 4; ++m) { sg[m] = acc[ai][0][m][n] * rs[ai][m] + shg; sv[m] = acc[ai][1][m][n] * rs[ai][m] + shv; }
#pragma unroll
                for (int m = 0; m < 4; ++m) {
                    const f32x4 gc = sg[m], vc = sv[m];
                    const f32x4 gpm = sg[m > 0 ? m - 1 : 0], vpm = sv[m > 0 ? m - 1 : 0];
                    const f32x4 gnm = sg[m < 3 ? m + 1 : 3], vnm = sv[m < 3 ? m + 1 : 3];
                    f32x4 gp, gn, vp, vn;
#pragma unroll
                    for (int j = 0; j < 4; ++j) {
                        gp[j] = lane_prev16(fr == 15 ? gpm[j] : gc[j], lane); gn[j] = lane_next16(fr == 0 ? gnm[j] : gc[j], lane);
                        vp[j] = lane_prev16(fr == 15 ? vpm[j] : vc[j], lane); vn[j] = lane_next16(fr == 0 ? vnm[j] : vc[j], lane); }
                    const f32x4 cg = w0g * gp + w1g * gc + w2g * gn + bg, cv = w0v * vp + w1v * vc + w2v * vn + bv;
                    float o[4];
#pragma unroll
                    for (int j = 0; j < 4; ++j) o[j] = cg[j] * __builtin_amdgcn_rcpf(1.f + __expf(-cg[j])) * cv[j];
                    uint2 w; w.x = cvt_pk_bf16(o[0], o[1]); w.y = cvt_pk_bf16(o[2], o[3]);
                    *(uint2*)(G + (size_t)(rowc + m * 16 + fr) * D_FF + oc) = w;
                    if (m == 0 && fr < 2) { float* r = RAW + ((size_t)chunk * 4 + fr) * D_FF2 + rg; *(f32x4*)r = gc; *(f32x4*)(r + HALF) = vc; }
                    if (m == 3 && fr >= 14) { float* r = RAW + ((size_t)chunk * 4 + (fr - 12)) * D_FF2 + rg; *(f32x4*)r = gc; *(f32x4*)(r + HALF) = vc; }
                }
            }
        }
    }
};

template <class Epi, class Sched, bool ALIGN_EPI = false, bool SP2 = false>
__device__ __forceinline__ void gemm_phase(PG8_LAS unsigned char* lds, const Gemm g, const Sched& S, const Epi& E) {
    int tid_o = threadIdx.x; asm volatile("" : "+v"(tid_o));
    const int tid = tid_o, wid = __builtin_amdgcn_readfirstlane(tid >> 6), lane = tid & 63, wr = wid >> 2, wc = wid & 3, fr = lane & 15, fq = lane >> 4;
    const int K = g.K, nt = K / BK;
    unsigned voffA[2], voffB[2];
#pragma unroll
    for (int i = 0; i < 2; ++i) { int R, C; stage_rc(tid * 16 + i * 8192, R, C); const int Rb = Epi::PERM ? ((R & ~31) + perm32(R & 31)) : R;
        voffA[i] = (unsigned)(R * K + C) * 2u; voffB[i] = (unsigned)(Rb * K + C) * 2u; }
    const size_t kstep = (size_t)(BK * 2);
    const size_t hstep = (size_t)HALF * K * 2;
    const size_t tstep = 2 * hstep;
    const unsigned ldsw = (unsigned)wid * 1024u;
    const int aoff = lds_byte(wr * 64 + fr, fq * 8), boff = lds_byte(wc * 32 + fr, fq * 8);
#define PG8_SA(b, h) (((b) * 2 + (h)) * HTB)
#define PG8_SB(b, h) ((4 + (b) * 2 + (h)) * HTB)
#define PG8_STAGE(bufoff, gbase, voff) do { _Pragma("unroll") for (int _i = 0; _i < 2; ++_i) \
        __builtin_amdgcn_global_load_lds((const unsigned*)((const char*)(gbase) + (voff)[_i]), (PG8_LAS unsigned*)(lds + (bufoff) + ldsw + _i * 8192), 16, 0, 0); } while (0)
#define PG8_LDA(dst, b, h) do { _Pragma("unroll") for (int m = 0; m < 4; ++m) _Pragma("unroll") for (int k = 0; k < 2; ++k) dst[m][k] = *(const PG8_LAS bf16x8*)(lds + PG8_SA(b, h) + aoff + m * 2048 + k * 1024); } while (0)
#define PG8_LDB(dst, b, h) do { _Pragma("unroll") for (int n = 0; n < 2; ++n) _Pragma("unroll") for (int k = 0; k < 2; ++k) dst[n][k] = *(const PG8_LAS bf16x8*)(lds + PG8_SB(b, h) + boff + n * 2048 + k * 1024); } while (0)
#define PG8_MMA(ai, bj, At, Bt) do { __builtin_amdgcn_s_setprio(1); _Pragma("unroll") for (int m = 0; m < 4; ++m) _Pragma("unroll") for (int n = 0; n < 2; ++n) _Pragma("unroll") for (int k = 0; k < 2; ++k) \
        acc[ai][bj][m][n] = __builtin_amdgcn_mfma_f32_16x16x32_bf16(Bt[n][k], At[m][k], acc[ai][bj][m][n], 0, 0, 0); __builtin_amdgcn_s_setprio(0); } while (0)
#define PG8_WAIT_V(n) asm volatile("s_waitcnt vmcnt(" #n ")" ::: "memory")
#define PG8_WAIT_L(n) asm volatile("s_waitcnt lgkmcnt(" #n ")" ::: "memory")
#define PG8_BAR __builtin_amdgcn_s_barrier()
#define PG8_SCHED __builtin_amdgcn_sched_barrier(0)
    Unit cur, nxt; int ui = 0;
    if (!S.next(0, cur)) return;
    f32x4 acc[2][2][4][2];
#pragma unroll
    for (int a = 0; a < 2; ++a)
#pragma unroll
        for (int b = 0; b < 2; ++b)
#pragma unroll
            for (int m = 0; m < 4; ++m)
#pragma unroll
                for (int n = 0; n < 2; ++n) acc[a][b][m][n] = (f32x4){0.f, 0.f, 0.f, 0.f};
    bf16x8 At[4][2], B0[2][2], B1[2][2];
    const char* cA = (const char*)g.A + (size_t)cur.pm * tstep; const char* cB = (const char*)g.Bt + (size_t)cur.pn * tstep;
    S.a_ready(cur);
    if constexpr (SP2) {
        PG8_STAGE(PG8_SB(0, 0), cB, voffB); PG8_STAGE(PG8_SB(0, 1), cB + hstep, voffB); PG8_STAGE(PG8_SA(0, 0), cA, voffA); PG8_STAGE(PG8_SA(0, 1), cA + hstep, voffA);
        if (wr == 1) PG8_BAR;
        PG8_WAIT_V(2); PG8_BAR;
        PG8_STAGE(PG8_SB(1, 0), cB + kstep, voffB); PG8_STAGE(PG8_SA(1, 0), cA + kstep, voffA); PG8_STAGE(PG8_SB(1, 1), cB + hstep + kstep, voffB);
        PG8_WAIT_V(6); PG8_BAR;
    } else {
        PG8_STAGE(PG8_SB(0, 0), cB, voffB); PG8_STAGE(PG8_SA(0, 0), cA, voffA); PG8_STAGE(PG8_SB(0, 1), cB + hstep, voffB); PG8_STAGE(PG8_SA(0, 1), cA + hstep, voffA);
        if (wr == 1) PG8_BAR;
        PG8_WAIT_V(4); PG8_BAR;
        PG8_STAGE(PG8_SB(1, 0), cB + kstep, voffB); PG8_STAGE(PG8_SA(1, 0), cA + kstep, voffA); PG8_STAGE(PG8_SB(1, 1), cB + hstep + kstep, voffB);
        PG8_WAIT_V(6); PG8_BAR;
    }
    for (;;) {
        const bool has_next = S.next(ui + 1, nxt);
        const char* nA = has_next ? (const char*)g.A + (size_t)nxt.pm * tstep : cA; const char* nB = has_next ? (const char*)g.Bt + (size_t)nxt.pn * tstep : cB;
        for (int t = 0; t < nt; t += 2) {
            const bool last = (t == nt - 2);
            const char* a1 = cA + (size_t)(t + 1) * kstep;
            const char* a2 = last ? nA : cA + (size_t)(t + 2) * kstep; const char* b2 = last ? nB : cB + (size_t)(t + 2) * kstep;
            const char* a3 = a2 + kstep; const char* b3 = b2 + kstep;
            if (last && has_next) S.a_ready(nxt);
            if constexpr (SP2) {
            PG8_LDB(B0, 0, 0); PG8_LDB(B1, 0, 1); PG8_SCHED; PG8_LDA(At, 0, 0); PG8_STAGE(PG8_SA(1, 1), a1 + hstep, voffA);
            PG8_WAIT_V(8); PG8_WAIT_L(0); PG8_BAR; PG8_MMA(0, 0, At, B0); PG8_MMA(0, 1, At, B1); PG8_BAR; PG8_SCHED;
            PG8_LDA(At, 0, 1); PG8_STAGE(PG8_SB(0, 0), b2, voffB); PG8_STAGE(PG8_SB(0, 1), b2 + hstep, voffB); PG8_STAGE(PG8_SA(0, 0), a2, voffA);
            PG8_WAIT_V(8); PG8_WAIT_L(0); PG8_BAR; PG8_MMA(1, 0, At, B0); PG8_MMA(1, 1, At, B1); PG8_BAR; PG8_SCHED;
            PG8_LDB(B0, 1, 0); PG8_LDB(B1, 1, 1); PG8_SCHED; PG8_LDA(At, 1, 0); PG8_STAGE(PG8_SA(0, 1), a2 + hstep, voffA);
            PG8_WAIT_V(8); PG8_WAIT_L(0); PG8_BAR; PG8_MMA(0, 0, At, B0); PG8_MMA(0, 1, At, B1); PG8_BAR; PG8_SCHED;
            PG8_LDA(At, 1, 1); PG8_STAGE(PG8_SB(1, 0), b3, voffB); PG8_STAGE(PG8_SB(1, 1), b3 + hstep, voffB); PG8_STAGE(PG8_SA(1, 0), a3, voffA);
            PG8_WAIT_V(8); PG8_WAIT_L(0); PG8_BAR; PG8_MMA(1, 0, At, B0); PG8_MMA(1, 1, At, B1); PG8_BAR; PG8_SCHED;
            } else {
            PG8_LDB(B0, 0, 0); PG8_SCHED; PG8_LDA(At, 0, 0); PG8_STAGE(PG8_SA(1, 1), a1 + hstep, voffA);
            PG8_WAIT_L(8); PG8_BAR; PG8_WAIT_L(0); PG8_MMA(0, 0, At, B0); PG8_BAR; PG8_SCHED;
            PG8_LDB(B1, 0, 1); PG8_STAGE(PG8_SB(0, 0), b2, voffB);
            PG8_BAR; PG8_WAIT_L(0); PG8_MMA(0, 1, At, B1); PG8_BAR;
            PG8_LDA(At, 0, 1); PG8_STAGE(PG8_SA(0, 0), a2, voffA);
            PG8_BAR; PG8_WAIT_L(0); PG8_MMA(1, 0, At, B0); PG8_BAR; PG8_SCHED;
            PG8_STAGE(PG8_SB(0, 1), b2 + hstep, voffB);
            PG8_WAIT_V(6); PG8_BAR; PG8_MMA(1, 1, At, B1); PG8_BAR;
            PG8_LDB(B0, 1, 0); PG8_SCHED; PG8_LDA(At, 1, 0); PG8_STAGE(PG8_SA(0, 1), a2 + hstep, voffA);
            PG8_WAIT_L(8); PG8_BAR; PG8_WAIT_L(0); PG8_MMA(0, 0, At, B0); PG8_BAR; PG8_SCHED;
            PG8_LDB(B1, 1, 1); PG8_STAGE(PG8_SB(1, 0), b3, voffB);
            PG8_BAR; PG8_WAIT_L(0); PG8_MMA(0, 1, At, B1); PG8_BAR;
            PG8_LDA(At, 1, 1); PG8_STAGE(PG8_SA(1, 0), a3, voffA);
            PG8_BAR; PG8_WAIT_L(0); PG8_MMA(1, 0, At, B0); PG8_BAR; PG8_SCHED;
            PG8_STAGE(PG8_SB(1, 1), b3 + hstep, voffB);
            PG8_WAIT_V(6); PG8_BAR; PG8_MMA(1, 1, At, B1); PG8_BAR;
            }
        }
        if constexpr (ALIGN_EPI) { if (wr == 0) PG8_BAR; }
        if constexpr (!Epi::AFTER_DRAIN) { E(acc, cur, wr, wc, fr, fq); S.done(cur); }
        if (!has_next) break;
#pragma unroll
        for (int a = 0; a < 2; ++a)
#pragma unroll
            for (int b = 0; b < 2; ++b)
#pragma unroll
                for (int m = 0; m < 4; ++m)
#pragma unroll
                    for (int n = 0; n < 2; ++n) acc[a][b][m][n] = (f32x4){0.f, 0.f, 0.f, 0.f};
        cur = nxt; cA = nA; cB = nB; ++ui;
        if constexpr (ALIGN_EPI) { if (wr == 1) PG8_BAR; }
    }
    PG8_WAIT_V(0);
    if constexpr (!ALIGN_EPI) { if (wr == 0) PG8_BAR; }
    PG8_BAR;
    if constexpr (Epi::AFTER_DRAIN) { E.fused(acc, cur, wr, wc, fr, fq, lds, wid, lane); S.done(cur); }
#undef PG8_SA
#undef PG8_SB
#undef PG8_STAGE
#undef PG8_LDA
#undef PG8_LDB
#undef PG8_MMA
#undef PG8_WAIT_V
#undef PG8_WAIT_L
#undef PG8_BAR
#undef PG8_SCHED
}

#define GAS __attribute__((address_space(1)))
#define LAS __attribute__((address_space(3)))
typedef unsigned v4u __attribute__((ext_vector_type(4)));
typedef GAS unsigned gu32;
typedef GAS unsigned long long gu64;
#define RLX_AGENT __ATOMIC_RELAXED, __HIP_MEMORY_SCOPE_AGENT
#define LDS_WAIT() asm volatile("s_waitcnt lgkmcnt(0)" ::: "memory")
#define VM_WAIT() asm volatile("s_waitcnt vmcnt(0)" ::: "memory")
__device__ __forceinline__ unsigned long long rt() { return __builtin_amdgcn_s_memrealtime(); }

#define XB_TMO      128
#define XB_XCNT(j)  (256  + 64 * (j))
#define XB_XSUB(j)  (1280 + 64 * (j))
#define XB_XGEN(j)  (2304 + 64 * (j))
#define XB_TOP      3328
#define XB_TOPGEN   3392
#define XCD_BAR_WORDS 3456
#define XB_SPIN_CAP (1u << 18)

__device__ __forceinline__ unsigned xb_ld(unsigned* p)              { return __hip_atomic_load(p, __ATOMIC_RELAXED, __HIP_MEMORY_SCOPE_AGENT); }
__device__ __forceinline__ unsigned xb_add(unsigned* p, unsigned v) { return __hip_atomic_fetch_add(p, v, __ATOMIC_RELAXED, __HIP_MEMORY_SCOPE_AGENT); }
__device__ __forceinline__ unsigned xb_xcc_id() { return (unsigned)__builtin_amdgcn_s_getreg((3 << 11) | 20) & 0xFu; }
#define XB_SPIN(cond, bar) do { unsigned _sp = 0; while (cond) { __builtin_amdgcn_s_sleep(1); \
    if ((++_sp & 255u) == 0u) { if (xb_ld(&(bar)[XB_TMO])) break; if (_sp > XB_SPIN_CAP) { atomicAdd(&(bar)[XB_TMO], 1u); break; } } } } while (0)

struct XcdBarrier {
    unsigned* bar; unsigned x;
    volatile LAS unsigned* st;
};

__device__ __forceinline__ XcdBarrier xcd_barrier_post(unsigned* bar, volatile LAS unsigned* st) {
    XcdBarrier b; b.bar = bar; b.x = xb_xcc_id(); b.st = st;
    if (threadIdx.x == 0) (void)xb_add(&bar[XB_XCNT(b.x)], 1u);
    return b;
}
__device__ __forceinline__ void xcd_barrier_complete(unsigned* bar, unsigned x, unsigned& nloc, unsigned& nx) {
    const unsigned G = gridDim.x * gridDim.y * gridDim.z;
    unsigned sum, cnt, mine, sp = 0u;
    for (;;) {
        sum = 0u; cnt = 0u; mine = 0u;
#pragma unroll
        for (unsigned j = 0; j < 16; ++j) { const unsigned c = xb_ld(&bar[XB_XCNT(j)]); sum += c; cnt += (c > 0u) ? 1u : 0u; mine = (j == x) ? c : mine; }
        if (sum == G) break;
        __builtin_amdgcn_s_sleep(1);
        if ((++sp & 255u) == 0u) { if (xb_ld(&bar[XB_TMO])) break; if (sp > XB_SPIN_CAP) { atomicAdd(&bar[XB_TMO], 1u); break; } }
    }
    nloc = mine > 0u ? mine : 1u; nx = cnt > 0u ? cnt : 1u;
}

__device__ __forceinline__ void xcd_barrier(const XcdBarrier& b) {
    asm volatile("s_waitcnt vmcnt(0)" ::: "memory");
    __syncthreads();
    if (threadIdx.x == 0) {
        unsigned* bar = b.bar;
        __builtin_amdgcn_s_waitcnt(0);
        unsigned nloc = b.st[0], nx = b.st[1];
        if (nloc == 0u) { xcd_barrier_complete(bar, b.x, nloc, nx); b.st[0] = nloc; b.st[1] = nx; }
        const unsigned old = xb_add(&bar[XB_XSUB(b.x)], 1u);
        const unsigned gen = old / nloc;
        if (old + 1u == (gen + 1u) * nloc) {
            __builtin_amdgcn_fence(__ATOMIC_RELEASE, "agent");
            asm volatile("s_waitcnt vmcnt(0)" ::: "memory");
            const unsigned og = xb_add(&bar[XB_TOP], 1u);
            const unsigned tg = og / nx;
            if (og + 1u == (tg + 1u) * nx) xb_add(&bar[XB_TOPGEN], 1u);
            else XB_SPIN(xb_ld(&bar[XB_TOPGEN]) == tg, bar);
            __builtin_amdgcn_fence(__ATOMIC_ACQUIRE, "agent");
            xb_add(&bar[XB_XGEN(b.x)], 1u);
            asm volatile("s_waitcnt vmcnt(0)" ::: "memory");
        } else {
            XB_SPIN(xb_ld(&bar[XB_XGEN(b.x)]) == gen, bar);
            __builtin_amdgcn_fence(__ATOMIC_ACQUIRE, "agent");
            asm volatile("s_waitcnt vmcnt(0)" ::: "memory");
        }
    }
    __syncthreads();
}

typedef LAS float lfloat;
__device__ __forceinline__ void transpose_item_l(const float* W, int K, int N, bf16_t* WT, bool upperm, lfloat* scr, int item, int lane) {
    const int nblk = N / 32, kb = item / nblk, nb = item % nblk, k0 = 64 * kb, n0 = 32 * nb;
    int r0 = n0;
    if (upperm) { r0 = (n0 < D_FF) ? (256 * (n0 / 128) + (n0 % 128)) : (256 * ((n0 - D_FF) / 128) + 128 + ((n0 - D_FF) % 128)); }
#pragma unroll 8
    for (int i = 0; i < 32; ++i) { const int kk = 2 * i + (lane >> 5); scr[kk * 33 + (lane & 31)] = W[(size_t)(k0 + kk) * N + n0 + (lane & 31)]; }
    asm volatile("s_waitcnt lgkmcnt(0)" ::: "memory");
    const int c = lane & 7;
#pragma unroll
    for (int j = 0; j < 4; ++j) { const int n = (lane >> 3) + 8 * j; const lfloat* s = scr + (8 * c) * 33 + n;
        u32x4 o; o.x = pk2(s[0 * 33], s[1 * 33]); o.y = pk2(s[2 * 33], s[3 * 33]); o.z = pk2(s[4 * 33], s[5 * 33]); o.w = pk2(s[6 * 33], s[7 * 33]);
        *(u32x4*)(WT + (size_t)(r0 + n) * K + k0 + 8 * c) = o; }
    asm volatile("s_waitcnt lgkmcnt(0)" ::: "memory");
}
__device__ __forceinline__ void wconv_phase(const Params& p, LAS unsigned char* lds, int vcu, int G) {
    int tid_o = threadIdx.x; asm volatile("" : "+v"(tid_o));
    const int lane = tid_o & 63, wave = __builtin_amdgcn_readfirstlane(tid_o >> 6);
    lfloat* scr = (lfloat*)lds + wave * 64 * 33;
    const int gw = vcu * NWAVES + wave, NGW = G * NWAVES;
    constexpr int I_IN = (DM / 64) * (D_IN / 32), I_OUT = (DM / 64) * (DM / 32), I_UP = (DM / 64) * (D_FF2 / 32), I_DN = (D_FF / 64) * (DM / 32);
    constexpr int PER_L = I_IN + I_OUT + I_UP + I_DN;
    for (int it = gw; it < DEPTH * PER_L; it += NGW) {
        const int l = it / PER_L; int r = it % PER_L;
        if (r < I_IN) { transpose_item_l(p.in[7] + (size_t)l * DM * D_IN, DM, D_IN, (bf16_t*)(p.ws + WS_WIN) + (size_t)l * D_IN * DM, false, scr, r, lane); continue; } r -= I_IN;
        if (r < I_OUT) { transpose_item_l(p.in[28] + (size_t)l * DM * DM, DM, DM, (bf16_t*)(p.ws + WS_WOUT) + (size_t)l * DM * DM, false, scr, r, lane); continue; } r -= I_OUT;
        if (r < I_UP) { transpose_item_l(p.in[30] + (size_t)l * DM * D_FF2, DM, D_FF2, (bf16_t*)(p.ws + WS_WUP) + (size_t)l * D_FF2 * DM, true, scr, r, lane); continue; } r -= I_UP;
        transpose_item_l(p.in[33] + (size_t)l * D_FF * DM, D_FF, DM, (bf16_t*)(p.ws + WS_WDN) + (size_t)l * DM * D_FF, false, scr, r, lane);
    }
    __syncthreads();
}
__device__ __forceinline__ void mod_phase(const Params& p, LAS unsigned char* lds, int vcu, int G) {
    int tid_o = threadIdx.x; asm volatile("" : "+v"(tid_o));
    const int tid = tid_o;
    lfloat* s = (lfloat*)lds;
    float* part = (float*)(p.ws + WS_A);
    for (int item = vcu; item < DEPTH * 32 * 12; item += G) {
        const int l = item / (32 * 12), rem = item % (32 * 12), kc = rem / 12, nc = rem % 12;
        const int k0 = kc * 32, n = nc * 512 + tid;
        __syncthreads();
        if (tid < 9 * 32) { const int r = tid / 32, kk = tid % 32;
            const float v = (r < 8) ? p.in[1][(size_t)r * DM + k0 + kk] : p.in[3][k0 + kk]; s[r * 32 + kk] = silu_f(v); }
        __syncthreads();
        float acc[9];
#pragma unroll
        for (int r = 0; r < 9; ++r) acc[r] = 0.f;
        const float* W = p.in[4] + ((size_t)l * DM + k0) * 6144 + n;
#pragma unroll 8
        for (int kk = 0; kk < 32; ++kk) { const float w = W[(size_t)kk * 6144];
#pragma unroll
            for (int r = 0; r < 9; ++r) acc[r] += s[r * 32 + kk] * w; }
#pragma unroll
        for (int r = 0; r < 9; ++r) part[(((size_t)l * 32 + kc) * 9 + r) * 6144 + n] = acc[r];
    }
    __syncthreads();
}
__device__ __forceinline__ void modred_phase(const Params& p, int vcu, int G) {
    const float* part = (const float*)(p.ws + WS_A);
    float* mod = (float*)(p.ws + WS_MOD);
    for (int e = vcu * 512 + (int)threadIdx.x; e < DEPTH * 9 * 6144; e += G * 512) {
        const int l = e / (9 * 6144), rn = e % (9 * 6144);
        float a = p.in[5][(size_t)l * 6144 + rn % 6144];
        for (int kc = 0; kc < 32; ++kc) a += part[((size_t)l * 32 + kc) * 9 * 6144 + rn];
        mod[e] = a;
    }
    bf16_t* shb = (bf16_t*)(p.ws + WS_SHB);
    for (int e = vcu * 512 + (int)threadIdx.x; e < 4 * 16 * 1024; e += G * 512) {
        const int combo = e >> 14, r = (e >> 10) & 15, k = e & 1023; float a = 0.f;
        if (r < 9) { const int l = combo >> 1, idx = ((combo & 1) ? 3072 : 0) + k; a = p.in[5][(size_t)l * 6144 + idx];
            for (int kc = 0; kc < 32; ++kc) a += part[(((size_t)l * 32 + kc) * 9 + r) * 6144 + idx]; }
        shb[e] = (bf16_t)f2bf(a);
    }
}
__device__ __forceinline__ void filters_item(const Params& p, lfloat* z, lfloat* h1, lfloat* h2, int tid, int l, int L, int pos0, int np, bool vec, bf16_t* R) {
    const int FLEN = 2 * L;
    const float* w1 = p.in[10] + (size_t)l * HY_EMB * HY_FFN; const float* b1 = p.in[11] + (size_t)l * HY_FFN;
    const float* w2 = p.in[12] + (size_t)l * HY_FFN * HY_FFN; const float* b2 = p.in[13] + (size_t)l * HY_FFN;
    const float* w3 = p.in[14] + (size_t)l * HY_FFN * 1024; const float* fr = p.in[15] + (size_t)l * HY_FFN;
    __syncthreads();
    for (int e = tid; e < np * HY_EMB; e += 512) { const int pp = e / HY_EMB, f = e % HY_EMB; const int pos = pos0 + pp;
        float v;
        if (f == 0) v = (float)pos / (float)(L - 1);
        else { const int k = (f - 1) & 15; const float band = 1e-4f + (float)k * ((15.f - 1e-4f) / 15.f);
               const float w = 6.283185307179586f * (float)pos / (float)L; const float a = band * w;
               v = (f <= 16) ? cosf(a) : -sinf(a); }
        z[pp * 34 + f] = v; }
    __syncthreads();
    for (int e = tid; e < np * HY_FFN; e += 512) { const int pp = e / HY_FFN, j = e % HY_FFN; float a = b1[j];
#pragma unroll 11
        for (int i = 0; i < HY_EMB; ++i) a += z[pp * 34 + i] * w1[i * HY_FFN + j];
        h1[pp * 64 + j] = sinf(fr[j] * a); }
    __syncthreads();
    for (int e = tid; e < np * HY_FFN; e += 512) { const int pp = e / HY_FFN, j = e % HY_FFN; float a = b2[j];
#pragma unroll 16
        for (int i = 0; i < HY_FFN; ++i) a += h1[pp * 64 + i] * w2[i * HY_FFN + j];
        h2[pp * 64 + j] = sinf(fr[j] * a); }
    __syncthreads();
    for (int o = tid; o < 1024; o += 512) {
        float acc[17];
#pragma unroll
        for (int pp = 0; pp < 17; ++pp) acc[pp] = 0.f;
        for (int k0 = 0; k0 < HY_FFN; k0 += 8) {
            float w[8];
#pragma unroll
            for (int k = 0; k < 8; ++k) w[k] = w3[(k0 + k) * 1024 + o];
#pragma unroll
            for (int pp = 0; pp < 17; ++pp) { const f32x4 ha = *(LAS const f32x4*)(h2 + pp * 64 + k0), hb = *(LAS const f32x4*)(h2 + pp * 64 + k0 + 4);
                acc[pp] += (ha.x * w[0] + ha.y * w[1]) + (ha.z * w[2] + ha.w * w[3]) + (hb.x * w[4] + hb.y * w[5]) + (hb.z * w[6] + hb.w * w[7]); }
        }
        const int order = o >> 9, dir = (o >> 8) & 1, c = o & 255;
        const float mind = -4.605170185988091f / 1.5f, maxd = -4.605170185988091f / 0.3f;
        const float delta = fabsf(mind + (float)c * ((maxd - mind) / 255.f));
        bf16_t* Rc = R + ((size_t)order * D_HY + c) * FLEN;
        float v[17];
#pragma unroll
        for (int pp = 0; pp < 17; ++pp) { const float t = (float)(pos0 + pp) / (float)(L - 1); v[pp] = acc[pp] * __expf(-t * delta); }
        if (vec) {
            if (dir == 0) {
                u32x4 a0, a1;
                a0.x = pk2(v[15], v[14]); a0.y = pk2(v[13], v[12]); a0.z = pk2(v[11], v[10]); a0.w = pk2(v[9], v[8]);
                a1.x = pk2(v[7], v[6]); a1.y = pk2(v[5], v[4]); a1.z = pk2(v[3], v[2]); a1.w = pk2(v[1], v[0]);
                bf16_t* d = Rc + (L - 16 - pos0); *(u32x4*)d = a0; *(u32x4*)(d + 8) = a1;
            } else {
                if (pos0 + 16 >= L) v[16] = 0.f;
                u32x4 a0, a1;
                a0.x = pk2(v[1], v[2]); a0.y = pk2(v[3], v[4]); a0.z = pk2(v[5], v[6]); a0.w = pk2(v[7], v[8]);
                a1.x = pk2(v[9], v[10]); a1.y = pk2(v[11], v[12]); a1.z = pk2(v[13], v[14]); a1.w = pk2(v[15], v[16]);
                bf16_t* d = Rc + (L + pos0); *(u32x4*)d = a0; *(u32x4*)(d + 8) = a1;
            }
        } else {
            const int pos = pos0;
            if (dir == 0) Rc[L - 1 - pos] = (bf16_t)f2bf(v[0]);
            else if (pos > 0) Rc[L - 1 + pos] = (bf16_t)f2bf(v[0]);
            if (pos0 == 0 && dir == 0) Rc[FLEN - 1] = 0;
        }
    }
}
__device__ __forceinline__ void filters_phase(const Params& p, LAS unsigned char* lds, int vcu, int G) {
    int tid_o = threadIdx.x; asm volatile("" : "+v"(tid_o));
    const int tid = tid_o;
    lfloat* z = (lfloat*)lds;
    lfloat* h1 = z + 17 * 34 + 2;
    lfloat* h2 = h1 + 17 * 64;
    for (int e = tid; e < 580 + 2 * 17 * 64; e += 512) z[e] = 0.f;
    for (int item = vcu; item < 512; item += G) {
        if (item < 256) { const int l = item >> 7; const int pos0 = (item & 127) * 16;
            filters_item(p, z, h1, h2, tid, l, SEQ, pos0, pos0 + 17 <= SEQ ? 17 : 16, true, (bf16_t*)(p.ws + WS_FILT) + (size_t)l * 2 * D_HY * FL); }
        else filters_item(p, z, h1, h2, tid, 0, CTXL, item - 256, 1, false, (bf16_t*)(p.ws + WS_FILTC));
    }
    __syncthreads();
    float* tab = (float*)(p.ws + WS_ROPE);
    for (int e = vcu * 512 + tid; e < SEQ * 32; e += G * 512) {
        const int pos = e >> 5, axis = (e >> 4) & 1, pr = e & 15;
        const float inv = exp2f(-(float)pr * (13.287712379549449f / 16.f));
        const float coord = axis == 0 ? (float)(pos / 64) : (float)(pos % 64);
        const float a = coord * inv;
        tab[2 * e] = cosf(a); tab[2 * e + 1] = sinf(a);
    }
}
__device__ __forceinline__ void norm0_phase(const Params& p, int vcu, int G) {
    int tid_o = threadIdx.x; asm volatile("" : "+v"(tid_o));
    const int lane = tid_o & 63, gw = vcu * NWAVES + (tid_o >> 6), NGW = G * NWAVES;
    const float* g = p.in[6];
    bf16_t* H = (bf16_t*)(p.ws + WS_HBF);
    unsigned long long* SS = (unsigned long long*)(p.ws + WS_SS);
    const float* MODl = (const float*)(p.ws + WS_MOD);
    f32x4 gv[4];
#pragma unroll
    for (int j = 0; j < 4; ++j) gv[j] = *(const f32x4*)(g + 4 * lane + 256 * j);
    for (int row = gw; row < MTOT; row += NGW) {
        const float* src; int mr;
        if (row < MLAT) { mr = row / SEQ; src = p.in[0] + (size_t)row * DM; }
        else { mr = 8; src = p.in[2] + (size_t)(row - MLAT) * DM; }
        f32x4 v[4]; float ss = 0.f;
#pragma unroll
        for (int j = 0; j < 4; ++j) { v[j] = *(const f32x4*)(src + 4 * lane + 256 * j); ss += (v[j].x * v[j].x + v[j].y * v[j].y) + (v[j].z * v[j].z + v[j].w * v[j].w); }
#pragma unroll
        for (int o = 1; o < 64; o <<= 1) ss += __shfl_xor(ss, o);
        if (lane == 0) SS[row] = (unsigned long long)(ss * SS_SCALE + 0.5f);
        const float* mrow = MODl + (size_t)mr * 6144;
#pragma unroll
        for (int j = 0; j < 4; ++j) { const int col = 4 * lane + 256 * j;
            const f32x4 sc = *(const f32x4*)(mrow + 1024 + col);
            const f32x4 y = v[j] * gv[j] * (1.f + sc);
            uint2 w; w.x = pk2(y.x, y.y); w.y = pk2(y.z, y.w);
            *(uint2*)(H + (size_t)row * DM + col) = w; }
    }
}
__device__ __forceinline__ void shw_phase(const Params& p, LAS unsigned char* lds, int vcu, int G) {
    typedef float f32x16 __attribute__((ext_vector_type(16)));
    int tid_o = threadIdx.x; asm volatile("" : "+v"(tid_o));
    const int tid = tid_o, lane = tid & 63, gw = vcu * NWAVES + (tid >> 6), NGW = G * NWAVES;
    constexpr int T_IN = D_IN / 32, T_UP = D_FF2 / 32, T_L = T_IN + T_UP;
    const int r = lane & 31, h = lane >> 5;
    for (int task = gw; task < DEPTH * T_L; task += NGW) {
        const int l = task / T_L, tt = task % T_L, which = tt >= T_IN ? 1 : 0, n0 = (which ? tt - T_IN : tt) * 32, combo = l * 2 + which;
        const bf16_t* Wt = (which ? (const bf16_t*)(p.ws + WS_WUP) + (size_t)l * D_FF2 * DM : (const bf16_t*)(p.ws + WS_WIN) + (size_t)l * D_IN * DM) + (size_t)(n0 + r) * DM + 8 * h;
        const bf16_t* ap = (const bf16_t*)(p.ws + WS_SHB) + ((size_t)combo * 16 + (r & 15)) * 1024 + 8 * h;
        f32x16 acc;
#pragma unroll
        for (int i = 0; i < 16; ++i) acc[i] = 0.f;
#pragma unroll 8
        for (int ks = 0; ks < 64; ++ks) { const bf16x8 bfr = *(const bf16x8*)(Wt + 16 * ks); const bf16x8 afr = *(const bf16x8*)(ap + 16 * ks);
            acc = __builtin_amdgcn_mfma_f32_32x32x16_bf16(afr, bfr, acc, 0, 0, 0); }
        float* dst = (float*)(p.ws + WS_SHW) + (size_t)combo * 9 * D_FF2 + n0 + r;
#pragma unroll
        for (int i = 0; i < 4; ++i) dst[(size_t)(i + 4 * h) * D_FF2] = acc[i];
        if (h == 0) dst[(size_t)8 * D_FF2] = acc[4];
    }
}
__device__ __forceinline__ void prep_qk_phase(const Params& p, int l, int nrows, int vcu, int G) {
    int tid_o = threadIdx.x; asm volatile("" : "+v"(tid_o));
    const int lane = tid_o & 63, gw = vcu * NWAVES + (tid_o >> 6), NGW = G * NWAVES;
    bf16_t* P = (bf16_t*)(p.ws + WS_A);
    const float* tab = (const float*)(p.ws + WS_ROPE);
    const int v = lane >> 2, quarter = lane & 3, axis = quarter >> 1, half = quarter & 1;
    const float* gn = (v < 8 ? p.in[21] : p.in[22]) + (size_t)l * QKD + quarter * 16;
    float g[16];
#pragma unroll
    for (int i = 0; i < 16; ++i) g[i] = gn[i];
    for (int row = gw; row < nrows; row += NGW) {
        bf16_t* ptr = P + (size_t)row * D_IN + COL_Q + v * 64 + quarter * 16;
        const u32x4 w0 = *(const u32x4*)ptr, w1 = *(const u32x4*)(ptr + 8);
        float x[16];
        x[0] = bflo(w0.x); x[1] = bfhi(w0.x); x[2] = bflo(w0.y); x[3] = bfhi(w0.y); x[4] = bflo(w0.z); x[5] = bfhi(w0.z); x[6] = bflo(w0.w); x[7] = bfhi(w0.w);
        x[8] = bflo(w1.x); x[9] = bfhi(w1.x); x[10] = bflo(w1.y); x[11] = bfhi(w1.y); x[12] = bflo(w1.z); x[13] = bfhi(w1.z); x[14] = bflo(w1.w); x[15] = bfhi(w1.w);
        float ss = 0.f;
#pragma unroll
        for (int i = 0; i < 16; ++i) ss += x[i] * x[i];
        ss += __shfl_xor(ss, 1); ss += __shfl_xor(ss, 2);
        const float rstd = rsqrtf(ss * (1.f / QKD) + EPS);
        float y[16];
#pragma unroll
        for (int i = 0; i < 16; ++i) y[i] = x[i] * rstd * g[i];
        if (row < MLAT) {
            const int pos = row % SEQ;
            const float* tp = tab + ((size_t)pos * 2 + axis) * 32;
#pragma unroll
            for (int i = 0; i < 16; ++i) { const float other = __shfl_xor(y[i], 1); const float c = tp[2 * i], s = tp[2 * i + 1];
                y[i] = half == 0 ? (y[i] * c - other * s) : (y[i] * c + other * s); }
        }
        const float sc = v < 8 ? QSCALE : 1.f;
        u32x4 o0, o1;
        o0.x = pk2(y[0] * sc, y[1] * sc); o0.y = pk2(y[2] * sc, y[3] * sc); o0.z = pk2(y[4] * sc, y[5] * sc); o0.w = pk2(y[6] * sc, y[7] * sc);
        o1.x = pk2(y[8] * sc, y[9] * sc); o1.y = pk2(y[10] * sc, y[11] * sc); o1.z = pk2(y[12] * sc, y[13] * sc); o1.w = pk2(y[14] * sc, y[15] * sc);
        *(u32x4*)ptr = o0; *(u32x4*)(ptr + 8) = o1;
    }
}
constexpr int HYP_LD = 72;
__device__ __forceinline__ void prep_hy_phase(const Params& p, int l, bool with_ctx, LAS unsigned char* lds, int vcu, int G) {
    int tid_o = threadIdx.x; asm volatile("" : "+v"(tid_o));
    const int tid = tid_o;
    LAS bf16_t* T = (LAS bf16_t*)lds;
    const bf16_t* P = (const bf16_t*)(p.ws + WS_A);
    const float* cw = p.in[8] + (size_t)l * 3 * IN_A; const float* cb = p.in[9] + (size_t)l * IN_A;
    const int nitems = 256 * 12 + (with_ctx ? 32 * 12 : 0);
    for (int item = vcu; item < nitems; item += G) {
        int b, t0, L, ct; size_t rowbase; bf16_t* dst; size_t which_stride;
        if (item < 256 * 12) { const int it = item / 12; ct = item % 12; b = it >> 5; t0 = (it & 31) * 64; L = SEQ; rowbase = (size_t)b * SEQ; dst = (bf16_t*)(p.ws + WS_HYT); which_stride = HYT_LAT_ELEMS; }
        else { const int it = (item - 256 * 12) / 12; ct = (item - 256 * 12) % 12; b = it >> 2; t0 = (it & 3) * 64; L = CTXL; rowbase = (size_t)MLAT + (size_t)b * CTXL; dst = (bf16_t*)(p.ws + WS_HYTC); which_stride = HYT_CTX_ELEMS; }
        __syncthreads();
        for (int ch = tid; ch < 66 * 8; ch += 512) { const int i = ch >> 3, part = ch & 7, t = t0 - 1 + i;
            u32x4 v = {0u, 0u, 0u, 0u};
            if (t >= 0 && t < L) v = *(const u32x4*)(P + (rowbase + t) * D_IN + ct * 64 + part * 8);
            *(LAS u32x4*)(T + i * HYP_LD + part * 8) = v; }
        __syncthreads();
        {   const int cl = tid & 63, tc = tid >> 6, c = ct * 64 + cl;
            const float w0 = cw[c], w1 = cw[IN_A + c], w2 = cw[2 * IN_A + c], bb = cb[c];
            float x[10];
#pragma unroll
            for (int i = 0; i < 10; ++i) x[i] = bf2f(T[(tc * 8 + i) * HYP_LD + cl]);
            float y[8];
#pragma unroll
            for (int i = 0; i < 8; ++i) y[i] = w0 * x[i] + w1 * x[i + 1] + w2 * x[i + 2] + bb;
            u32x4 o; o.x = pk2(y[0], y[1]); o.y = pk2(y[2], y[3]); o.z = pk2(y[4], y[5]); o.w = pk2(y[6], y[7]);
            *(u32x4*)(dst + (size_t)(c >> 8) * which_stride + ((size_t)(c & 255) * NB + b) * L + t0 + tc * 8) = o; }
    }
    __syncthreads();
}
constexpr int SGU_LD = 136;
__device__ __forceinline__ void sgu_phase(const Params& p, int l, int nitems, LAS unsigned char* lds, int vcu, int G) {
    typedef float f32x16 __attribute__((ext_vector_type(16)));
    int tid_o = threadIdx.x; asm volatile("" : "+v"(tid_o));
    const int tid = tid_o, lane = tid & 63, wave = __builtin_amdgcn_readfirstlane(tid >> 6);
    LAS bf16_t* VT = (LAS bf16_t*)lds;
    const bf16_t* P = (const bf16_t*)(p.ws + WS_A);
    bf16_t* MIX = (bf16_t*)(p.ws + WS_MIX);
    const int r = lane & 31, h = lane >> 5, g = wave >> 1, dt = wave & 1;
    for (int item = vcu; item < nitems; item += G) {
        const size_t row0 = item < 128 ? (size_t)item * 128 : (size_t)MLAT + (size_t)(item - 128) * 128;
        __syncthreads();
        {   const int q = tid >> 2, dq = tid & 3;
#pragma unroll
            for (int gg = 0; gg < 4; ++gg) {
                const bf16_t* src = P + (row0 + q) * D_IN + IN_A + D_SG + gg * 64 + dq * 16;
                const u32x4 w0 = *(const u32x4*)src, w1 = *(const u32x4*)(src + 8);
                float x[16];
                x[0] = bflo(w0.x); x[1] = bfhi(w0.x); x[2] = bflo(w0.y); x[3] = bfhi(w0.y); x[4] = bflo(w0.z); x[5] = bfhi(w0.z); x[6] = bflo(w0.w); x[7] = bfhi(w0.w);
                x[8] = bflo(w1.x); x[9] = bfhi(w1.x); x[10] = bflo(w1.y); x[11] = bfhi(w1.y); x[12] = bflo(w1.z); x[13] = bfhi(w1.z); x[14] = bflo(w1.w); x[15] = bfhi(w1.w);
                float sm = 0.f;
#pragma unroll
                for (int i = 0; i < 16; ++i) { x[i] = gelu_tanh(x[i]); sm += x[i]; }
                sm += __shfl_xor(sm, 1); sm += __shfl_xor(sm, 2);
                const float mu = sm * (1.f / 64.f); float s2 = 0.f;
#pragma unroll
                for (int i = 0; i < 16; ++i) { x[i] -= mu; s2 += x[i] * x[i]; }
                s2 += __shfl_xor(s2, 1); s2 += __shfl_xor(s2, 2);
                const float rstd = rsqrtf(s2 * (1.f / 64.f) + EPS);
                const float* lg = p.in[17] + ((size_t)l * 4 + gg) * 64 + dq * 16; const float* lb = p.in[18] + ((size_t)l * 4 + gg) * 64 + dq * 16;
#pragma unroll
                for (int i = 0; i < 16; ++i) VT[(gg * 64 + dq * 16 + i) * SGU_LD + q] = (bf16_t)f2bf(x[i] * rstd * lg[i] + lb[i]);
            }
        }
        __syncthreads();
        bf16x8 bfr[8];
        { LAS const bf16_t* bp = VT + (g * 64 + 32 * dt + r) * SGU_LD + 8 * h;
#pragma unroll
          for (int ks = 0; ks < 8; ++ks) bfr[ks] = *(LAS const bf16x8*)(bp + 16 * ks); }
        const int d = 32 * dt + r;
#pragma unroll 1
        for (int pt = 0; pt < 4; ++pt) {
            const float* Wp = p.in[19] + (((size_t)l * 4 + g) * 128 + 32 * pt + r) * 128 + 8 * h;
            f32x16 acc;
#pragma unroll
            for (int i = 0; i < 16; ++i) acc[i] = 0.f;
#pragma unroll
            for (int ks = 0; ks < 8; ++ks) { const f32x4 a0 = *(const f32x4*)(Wp + 16 * ks), a1 = *(const f32x4*)(Wp + 16 * ks + 4);
                u32x4 w; w.x = cvt_pk_bf16(a0.x, a0.y); w.y = cvt_pk_bf16(a0.z, a0.w); w.z = cvt_pk_bf16(a1.x, a1.y); w.w = cvt_pk_bf16(a1.z, a1.w);
                acc = __builtin_amdgcn_mfma_f32_32x32x16_bf16(__builtin_bit_cast(bf16x8, w), bfr[ks], acc, 0, 0, 0); }
            const float* bsp = p.in[20] + ((size_t)l * 4 + g) * 128 + 32 * pt + 4 * h;
            const bf16_t* up = P + (row0 + 32 * pt + 4 * h) * D_IN + IN_A + g * 64 + d;
            bf16_t* op = MIX + (row0 + 32 * pt + 4 * h) * DM + D_HY + g * 64 + d;
#pragma unroll
            for (int i = 0; i < 16; ++i) { const int pr = (i & 3) + 8 * (i >> 2);
                const float u = gelu_tanh(bf2f(up[(size_t)pr * D_IN]));
                op[(size_t)pr * DM] = (bf16_t)f2bf(u * (acc[i] + bsp[pr])); }
        }
    }
    __syncthreads();
}

namespace att {
typedef short s16x4 __attribute__((ext_vector_type(4)));
typedef float f32x16 __attribute__((ext_vector_type(16)));
constexpr int KVBLK = 64, SHM_T = 16384;
constexpr int OFF_V = 0, OFF_K = 2 * SHM_T, OFF_STAGE = 0, STAGE_LD = 132, OFF_SCR = 69632;
#define KSWZ(row, colB) ((row) * 256 + ((colB) ^ (((row) & 7) << 4)))
#define SBAR() __builtin_amdgcn_sched_barrier(0)
__device__ __forceinline__ int crow(int r, int hi) { return (r & 3) + 8 * (r >> 2) + 4 * hi; }
__device__ __forceinline__ int v_st(int k, int c) { const int kk = (k & ~0xC) | ((k & 4) << 1) | ((k & 8) >> 1); return ((kk >> 3) * 4 + (c >> 5)) * 512 + ((kk & 7) * 32 + (c & 31)) * 2; }
__device__ __forceinline__ int v_rd_base(int lane) { return ((lane & 3) << 3) | (((lane >> 2) & 3) << 6) | (((lane >> 4) & 1) << 5) | (((lane >> 5) & 1) << 8); }
constexpr int v_rd_off(int d0, int ks, int half) { return d0 * 512 + ks * 4096 + half * 2048; }
template <int OFF> __device__ __forceinline__ s16x4 tr_read(int vb) {
    s16x4 r; asm volatile("ds_read_b64_tr_b16 %0, %1 offset:%2" : "=&v"(r) : "v"(vb), "i"(OFF) : "memory"); return r; }
template <int D0> __device__ __forceinline__ void pv_one(f32x16& od, int vb, bf16x8 pa0, bf16x8 pa1, bf16x8 pa2, bf16x8 pa3) {
    const s16x4 l0 = tr_read<v_rd_off(D0, 0, 0)>(vb), h0 = tr_read<v_rd_off(D0, 0, 1)>(vb), l1 = tr_read<v_rd_off(D0, 1, 0)>(vb), h1 = tr_read<v_rd_off(D0, 1, 1)>(vb);
    const s16x4 l2 = tr_read<v_rd_off(D0, 2, 0)>(vb), h2 = tr_read<v_rd_off(D0, 2, 1)>(vb), l3 = tr_read<v_rd_off(D0, 3, 0)>(vb), h3 = tr_read<v_rd_off(D0, 3, 1)>(vb);
    asm volatile("s_waitcnt lgkmcnt(0)" ::: "memory"); SBAR();
#define PK(L, H) (bf16x8){L[0], L[1], L[2], L[3], H[0], H[1], H[2], H[3]}
    od = __builtin_amdgcn_mfma_f32_32x32x16_bf16(pa0, PK(l0, h0), od, 0, 0, 0);
    od = __builtin_amdgcn_mfma_f32_32x32x16_bf16(pa1, PK(l1, h1), od, 0, 0, 0);
    od = __builtin_amdgcn_mfma_f32_32x32x16_bf16(pa2, PK(l2, h2), od, 0, 0, 0);
    od = __builtin_amdgcn_mfma_f32_32x32x16_bf16(pa3, PK(l3, h3), od, 0, 0, 0);
#undef PK
}
__device__ __forceinline__ void tile_compute(f32x16 (&o)[4], float& l_reg, const bf16x8 (&qr)[4], const f32x16& negm, LAS const unsigned char* Kt, int vb, int kcb, int r32) {
    f32x16 p0, p1;
#pragma unroll
    for (int d0 = 0; d0 < 4; ++d0) { const int cb = kcb + d0 * 32;
        const bf16x8 b0 = *(LAS const bf16x8*)(Kt + KSWZ(r32, cb)); const bf16x8 b1 = *(LAS const bf16x8*)(Kt + KSWZ(32 + r32, cb));
        if (d0 == 0) { p0 = __builtin_amdgcn_mfma_f32_32x32x16_bf16(b0, qr[0], negm, 0, 0, 0); p1 = __builtin_amdgcn_mfma_f32_32x32x16_bf16(b1, qr[0], negm, 0, 0, 0); }
        else { p0 = __builtin_amdgcn_mfma_f32_32x32x16_bf16(b0, qr[d0], p0, 0, 0, 0); p1 = __builtin_amdgcn_mfma_f32_32x32x16_bf16(b1, qr[d0], p1, 0, 0, 0); } }
#pragma unroll
    for (int r = 0; r < 16; ++r) { p0[r] = __builtin_amdgcn_exp2f(p0[r]); p1[r] = __builtin_amdgcn_exp2f(p1[r]); }
    float ps = 0.f;
#pragma unroll
    for (int r = 0; r < 16; ++r) ps += p0[r] + p1[r];
    l_reg += ps;
    bf16x8 pa0, pa1, pa2, pa3;
#define PK4(P, BASE, OUT) do { unsigned a0 = cvt_pk_bf16(P[BASE + 0], P[BASE + 1]), a1 = cvt_pk_bf16(P[BASE + 2], P[BASE + 3]);   \
    unsigned b0_ = cvt_pk_bf16(P[BASE + 4], P[BASE + 5]), b1_ = cvt_pk_bf16(P[BASE + 6], P[BASE + 7]);                              \
    auto r0 = __builtin_amdgcn_permlane32_swap(a0, b0_, false, false); auto r1 = __builtin_amdgcn_permlane32_swap(a1, b1_, false, false); \
    u32x4 w = {r0[0], r1[0], r0[1], r1[1]}; OUT = __builtin_bit_cast(bf16x8, w); } while (0)
    PK4(p0, 0, pa0); PK4(p0, 8, pa1); PK4(p1, 0, pa2); PK4(p1, 8, pa3);
#undef PK4
    pv_one<0>(o[0], vb, pa0, pa1, pa2, pa3); pv_one<1>(o[1], vb, pa0, pa1, pa2, pa3); pv_one<2>(o[2], vb, pa0, pa1, pa2, pa3); pv_one<3>(o[3], vb, pa0, pa1, pa2, pa3);
}
struct Stg { u32x4 vs0, vs1, ks0, ks1; };
__device__ __forceinline__ void attn_unit(const Params& p, int l, int b, int h, int q0, bool ctxu, LAS unsigned char* lds, float lam, float lam_init, float M2) {
    int tid_o = threadIdx.x; asm volatile("" : "+v"(tid_o));
    const int tid = tid_o, lane = tid & 63, r32 = lane & 31, hi = lane >> 5;
    const int wid = __builtin_amdgcn_readfirstlane(tid >> 6), comp = wid >> 2, wq = wid & 3;
    const bf16_t* P = (const bf16_t*)(p.ws + WS_A);
    const size_t lat0 = (size_t)b * SEQ, ctx0 = (size_t)MLAT + (size_t)b * CTXL;
    const size_t qrow0 = (ctxu ? ctx0 : lat0) + q0 + wq * 32;
    const int NT = ctxu ? CTXL / KVBLK : (SEQ + CTXL) / KVBLK;
    LAS unsigned char* V_lds = lds + OFF_V; LAS unsigned char* K_lds = lds + OFF_K;
    LAS float* scr = (LAS float*)(lds + OFF_SCR) + wid * 64;
    bf16x8 qr[4];
    { const bf16_t* Qw = P + (qrow0 + r32) * D_IN + COL_Q + h * 128 + comp * 64 + hi * 8;
#pragma unroll
      for (int d0 = 0; d0 < 4; ++d0) qr[d0] = *(const bf16x8*)(Qw + d0 * 16); }
    f32x16 negm;
#pragma unroll
    for (int r = 0; r < 16; ++r) negm[r] = -M2;
    f32x16 o[4];
#pragma unroll
    for (int d = 0; d < 4; ++d)
#pragma unroll
        for (int r = 0; r < 16; ++r) o[d][r] = 0.f;
    float l_reg = 0.f;
    const int sr = tid >> 4, sc = (tid & 15) * 8;
    const int vst0 = v_st(sr, sc), vst1 = v_st(32 + sr, sc), kst0 = KSWZ(sr, sc * 2), kst1 = KSWZ(32 + sr, sc * 2);
    const int vb0 = (int)(unsigned)(uintptr_t)V_lds + v_rd_base(lane);
    const int kcb = (comp * 64 + hi * 8) * 2;
    const bf16_t* Kg = P + COL_K + h * 128 + sc; const bf16_t* Vg = P + COL_V + h * 128 + sc;
#define KROW(t_, rr) ((ctxu || (t_) >= SEQ / KVBLK) ? (ctx0 + (size_t)((t_) - (ctxu ? 0 : SEQ / KVBLK)) * KVBLK + (rr)) : (lat0 + (size_t)(t_) * KVBLK + (rr)))
#define SLOAD(S, t_) do { const size_t ra = KROW(t_, sr) * D_IN, rb = KROW(t_, 32 + sr) * D_IN; \
        S.vs0 = *(const u32x4*)(Vg + ra); S.vs1 = *(const u32x4*)(Vg + rb); S.ks0 = *(const u32x4*)(Kg + ra); S.ks1 = *(const u32x4*)(Kg + rb); } while (0)
#define SWRITE(bf, S) do { *(LAS u32x4*)(V_lds + (bf) * SHM_T + vst0) = S.vs0; *(LAS u32x4*)(V_lds + (bf) * SHM_T + vst1) = S.vs1; \
        *(LAS u32x4*)(K_lds + (bf) * SHM_T + kst0) = S.ks0; *(LAS u32x4*)(K_lds + (bf) * SHM_T + kst1) = S.ks1; } while (0)
    Stg s0, s1;
    SLOAD(s0, 0); SWRITE(0, s0);
    SLOAD(s0, 1); SLOAD(s1, 2);
    __syncthreads();
    for (int j = 0; j < NT; j += 2) {
        SWRITE(1, s0); if (j + 3 < NT) SLOAD(s0, j + 3);
        tile_compute(o, l_reg, qr, negm, K_lds, vb0, kcb, r32);
        __syncthreads();
        if (j + 2 < NT) { SWRITE(0, s1); if (j + 4 < NT) SLOAD(s1, j + 4); }
        tile_compute(o, l_reg, qr, negm, K_lds + SHM_T, vb0 + SHM_T, kcb, r32);
        __syncthreads();
    }
#undef SLOAD
#undef SWRITE
#undef KROW
    const float lt = l_reg + __shfl_xor(l_reg, 32);
    const float rl = (comp == 0 ? 1.f : lam) / lt;
    if (hi == 0) scr[r32] = rl;
    asm volatile("s_waitcnt lgkmcnt(0)" ::: "memory");
    float rli[16];
#pragma unroll
    for (int r = 0; r < 16; ++r) rli[r] = scr[crow(r, hi)];
    LAS float* stage = (LAS float*)(lds + OFF_STAGE) + wq * 32 * STAGE_LD;
    if (comp == 1) {
#pragma unroll
        for (int d0 = 0; d0 < 4; ++d0)
#pragma unroll
            for (int r = 0; r < 16; ++r) stage[crow(r, hi) * STAGE_LD + 32 * d0 + r32] = o[d0][r] * rli[r];
    }
    __syncthreads();
    if (comp == 0) {
#pragma unroll
        for (int d0 = 0; d0 < 4; ++d0)
#pragma unroll
            for (int r = 0; r < 16; ++r) { const int idx = crow(r, hi) * STAGE_LD + 32 * d0 + r32; stage[idx] = o[d0][r] * rli[r] - stage[idx]; }
        asm volatile("s_waitcnt lgkmcnt(0)" ::: "memory");
        const int row = lane >> 1, half = lane & 1;
        f32x4 v[16]; float ss = 0.f;
#pragma unroll
        for (int i = 0; i < 16; ++i) { v[i] = *(LAS const f32x4*)(stage + row * STAGE_LD + half * 64 + 4 * i); ss += (v[i].x * v[i].x + v[i].y * v[i].y) + (v[i].z * v[i].z + v[i].w * v[i].w); }
        ss += __shfl_xor(ss, 1);
        const float rstd = rsqrtf(ss * (1.f / VD) + EPS) * (1.f - lam_init);
        const float* gs = p.in[27] + (size_t)l * VD + half * 64;
        bf16_t* dst = (bf16_t*)(p.ws + WS_MIX) + (qrow0 + row) * DM + 512 + h * 128 + half * 64;
#pragma unroll
        for (int i = 0; i < 8; ++i) { const f32x4 g0 = *(const f32x4*)(gs + 8 * i), g1 = *(const f32x4*)(gs + 8 * i + 4); const f32x4 a = v[2 * i] * rstd * g0, c = v[2 * i + 1] * rstd * g1;
            u32x4 w; w.x = cvt_pk_bf16(a.x, a.y); w.y = cvt_pk_bf16(a.z, a.w); w.z = cvt_pk_bf16(c.x, c.y); w.w = cvt_pk_bf16(c.z, c.w);
            *(u32x4*)(dst + 8 * i) = w; }
    }
    __syncthreads();
}
__device__ __forceinline__ void attn_scalars(const Params& p, int l, int lane, float& lam, float& lam_init, float& M2) {
    float s1 = p.in[23][l * QKD + lane] * p.in[24][l * QKD + lane], s2 = p.in[25][l * QKD + lane] * p.in[26][l * QKD + lane];
    float gq = fabsf(p.in[21][l * QKD + lane]), gk = fabsf(p.in[22][l * QKD + lane]);
#pragma unroll
    for (int o = 1; o < 64; o <<= 1) { s1 += __shfl_xor(s1, o); s2 += __shfl_xor(s2, o); gq = fmaxf(gq, __shfl_xor(gq, o)); gk = fmaxf(gk, __shfl_xor(gk, o)); }
    lam_init = 0.8f - 0.6f * expf(-0.3f * (float)l);
    lam = expf(s1) - expf(s2) + lam_init;
    M2 = 8.f * gq * gk * LOG2E;
}
__device__ __forceinline__ void attn_phase(const Params& p, int l, LAS unsigned char* lds, int vcu, int G, bool with_ctx) {
    float lam, lam_init, M2; attn_scalars(p, l, threadIdx.x & 63, lam, lam_init, M2);
    const int nunits = 512 + (with_ctx ? 64 : 0);
    for (int u = vcu; u < nunits; u += G) {
        if (u < 512) attn_unit(p, l, u >> 6, (u >> 4) & 3, (u & 15) * 128, false, lds, lam, lam_init, M2);
        else { const int v = u - 512; attn_unit(p, l, v >> 3, (v >> 1) & 3, (v & 1) * 128, true, lds, lam, lam_init, M2); }
    }
}
#undef KSWZ
#undef SBAR
}

namespace hyc {
typedef float f32x16 __attribute__((ext_vector_type(16)));
constexpr int UOFF = 65536, UBLK = 640, ROFF = UOFF + 70 * UBLK;
__device__ __forceinline__ int crow(int r, int hi) { return (r & 3) + 8 * (r >> 2) + 4 * hi; }
__device__ __forceinline__ void conv_unit(const Params& p, int l, int order, int c, bool ctxu, LAS unsigned char* lds) {
    int tid_o = threadIdx.x; asm volatile("" : "+v"(tid_o));
    const int tid = tid_o, lane = tid & 63, wave = __builtin_amdgcn_readfirstlane(tid >> 6);
    const int L = ctxu ? CTXL : SEQ, nblk = L >> 5, FLEN = 2 * L;
    const bf16_t* R = ctxu ? (const bf16_t*)(p.ws + WS_FILTC) + ((size_t)order * D_HY + c) * FLEN
                           : (const bf16_t*)(p.ws + WS_FILT) + (((size_t)l * 2 + order) * D_HY + c) * FLEN;
    bf16_t* HY = ctxu ? (bf16_t*)(p.ws + WS_HYTC) : (bf16_t*)(p.ws + WS_HYT);
    const size_t wst = ctxu ? HYT_CTX_ELEMS : HYT_LAT_ELEMS;
    const size_t coff = (size_t)c * NB * L;
    const bf16_t* Uin = HY + (order == 0 ? 0 : 3) * wst + coff;
    const bf16_t* Xg = HY + (order == 0 ? 1 : 2) * wst + coff;
    for (int i = tid; i < FLEN / 8; i += 512) *(LAS u32x4*)(lds + ROFF + 16 * i) = *(const u32x4*)(R + 8 * i);
    if (tid < 8) *(LAS unsigned*)(lds + ROFF + FLEN * 2 + 4 * tid) = 0u;
    for (int ch = tid; ch < L; ch += 512) { const int b = ch / (L >> 3), s = (ch % (L >> 3)) * 8;
        const u32x4 v = *(const u32x4*)(Uin + (size_t)b * L + s);
        *(LAS u32x4*)(lds + UOFF + ((s >> 5) + 3) * UBLK + ((s >> 4) & 1) * 256 + ((s >> 3) & 1) * 128 + b * 16) = v; }
    if (tid < 240) { const int blk = tid / 40, w = tid % 40; const int J = blk < 3 ? blk - 3 : nblk + (blk - 3);
        *(LAS u32x4*)(lds + UOFF + (J + 3) * UBLK + w * 16) = (u32x4){0u, 0u, 0u, 0u}; }
    __syncthreads();
    for (int e = tid; e < FLEN; e += 512) {
        LAS const unsigned* r32p = (LAS const unsigned*)(lds + ROFF) + (e >> 1);
        const unsigned d0 = r32p[0], d1 = r32p[1], d2 = r32p[2], d3 = r32p[3], d4 = r32p[4];
        u32x4 w;
        if (e & 1) { w.x = __builtin_amdgcn_alignbit(d1, d0, 16); w.y = __builtin_amdgcn_alignbit(d2, d1, 16); w.z = __builtin_amdgcn_alignbit(d3, d2, 16); w.w = __builtin_amdgcn_alignbit(d4, d3, 16); }
        else { w.x = d0; w.y = d1; w.z = d2; w.w = d3; }
        *(LAS u32x4*)(lds + 16 * e) = w; }
    __syncthreads();
    const int r = lane & 31, h = lane >> 5, bb = lane & 7, q = (lane >> 3) & 3;
    const float bias = p.in[16][((size_t)l * 2 + order) * D_HY + c];
    for (int g = wave; g < (nblk >> 2); g += 8) {
        const int I0 = 4 * g;
        f32x16 acc;
#pragma unroll
        for (int i = 0; i < 16; ++i) acc[i] = 0.f;
        const int dlo = I0 - (nblk - 1), dhi = I0 + 3;
        LAS const unsigned char* ap = lds + 16 * ((L - 1) - 32 * dlo - r + 8 * h);
        LAS const unsigned char* bp = lds + UOFF + (I0 + q - dlo + 3) * UBLK + h * 128 + bb * 16;
        for (int d = dlo; d <= dhi; ++d) {
            const bf16x8 a0 = *(LAS const bf16x8*)(ap), a1 = *(LAS const bf16x8*)(ap + 256);
            const bf16x8 b0 = *(LAS const bf16x8*)(bp), b1 = *(LAS const bf16x8*)(bp + 256);
            acc = __builtin_amdgcn_mfma_f32_32x32x16_bf16(a0, b0, acc, 0, 0, 0);
            acc = __builtin_amdgcn_mfma_f32_32x32x16_bf16(a1, b1, acc, 0, 0, 0);
            ap -= 512; bp -= UBLK;
        }
        const int tb = 32 * (I0 + q) + 4 * h;
        const size_t boff = (size_t)bb * L;
#pragma unroll
        for (int gq = 0; gq < 4; ++gq) {
            const int t = tb + 8 * gq;
            const uint2 xu = *(const uint2*)(Xg + boff + t), uu = *(const uint2*)(Uin + boff + t);
            float o[4];
            o[0] = bflo(xu.x) * (acc[4 * gq + 0] + bias * bflo(uu.x)); o[1] = bfhi(xu.x) * (acc[4 * gq + 1] + bias * bfhi(uu.x));
            o[2] = bflo(xu.y) * (acc[4 * gq + 2] + bias * bflo(uu.y)); o[3] = bfhi(xu.y) * (acc[4 * gq + 3] + bias * bfhi(uu.y));
            if (order == 0) { uint2 w; w.x = cvt_pk_bf16(o[0], o[1]); w.y = cvt_pk_bf16(o[2], o[3]); *(uint2*)(HY + 3 * wst + coff + boff + t) = w; }
            else { bf16_t* mx = (bf16_t*)(p.ws + WS_MIX) + ((ctxu ? (size_t)MLAT + (size_t)bb * CTXL : (size_t)bb * SEQ) + t) * DM + c;
#pragma unroll
                   for (int j = 0; j < 4; ++j) mx[(size_t)j * DM] = (bf16_t)f2bf(o[j]); }
        }
    }
    __syncthreads();
}
__device__ __forceinline__ void conv_phase(const Params& p, int l, LAS unsigned char* lds, int vcu, int G, bool with_ctx) {
    for (int c = vcu; c < D_HY; c += G) {
        conv_unit(p, l, 0, c, false, lds); if (with_ctx) conv_unit(p, l, 0, c, true, lds);
        asm volatile("s_waitcnt vmcnt(0)" ::: "memory"); __syncthreads();
        conv_unit(p, l, 1, c, false, lds); if (with_ctx) conv_unit(p, l, 1, c, true, lds);
    }
}
}

constexpr int RING_OFF = 0, RING_BYTES = 131072;
constexpr int LDSCTL_OFF = RING_BYTES, MISC_OFF = LDSCTL_OFF + 320;
constexpr int LDS_BYTES = 147456;
constexpr int CW_BAR = 131072;
constexpr size_t WS_RAW = WS_B + 36 * MiB;

struct MkArgs { Params p; int ph_lo, ph_hi, li, sub; };

enum Phase { PH_PRO_A = 0, PH_PRO_B = 1, PH_N0 = 2, PH_L0 = 3, PHL_GEMM_IN = 0, PHL_PREP = 1, PHL_MIX1 = 2, PHL_GEMM_OUT = 3, PHL_GEMM_UP = 4, PHL_GEMM_DOWN = 5, PHL_N = 6, PH_TOTAL = 3 + 2 * 6 };

__device__ __forceinline__ void fixup_phase(const Params& p, int l, int q0, int nchunks, int wid_g, int nw_g, int lane) {
    const float* RAW = (const float*)(p.ws + WS_RAW); bf16_t* G = (bf16_t*)(p.ws + WS_A);
    const float* cw = p.in[31] + (size_t)l * 3 * D_FF2; const float* cb = p.in[32] + (size_t)l * D_FF2;
    const int nitems = nchunks * 2 * 11;
    for (int it = wid_g; it < nitems; it += nw_g) {
        const int slab = it % 11, rw = (it / 11) & 1, q = q0 + it / 22;
        const int row = q * 64 + (rw ? 63 : 0);
        const int L = row < MLAT ? SEQ : CTXL, t = row < MLAT ? row % SEQ : (row - MLAT) % CTXL;
        const int o = slab * 256 + lane * 4;
        const int rg = 256 * (o / 128) + (o % 128);
        const float* rp; const float* rc; const float* rn; bool hp, hn;
        if (!rw) { hp = t > 0; rp = RAW + ((size_t)(q - 1) * 4 + 3) * D_FF2; rc = RAW + ((size_t)q * 4 + 0) * D_FF2; rn = RAW + ((size_t)q * 4 + 1) * D_FF2; hn = true; }
        else { hp = true; rp = RAW + ((size_t)q * 4 + 2) * D_FF2; rc = RAW + ((size_t)q * 4 + 3) * D_FF2; hn = t < L - 1; rn = RAW + ((size_t)(q + 1) * 4 + 0) * D_FF2; }
        const f32x4 z = {0.f, 0.f, 0.f, 0.f};
        const f32x4 gp = hp ? *(const f32x4*)(rp + rg) : z, vp = hp ? *(const f32x4*)(rp + rg + 128) : z;
        const f32x4 gc = *(const f32x4*)(rc + rg), vc = *(const f32x4*)(rc + rg + 128);
        const f32x4 gn = hn ? *(const f32x4*)(rn + rg) : z, vn = hn ? *(const f32x4*)(rn + rg + 128) : z;
        const f32x4 cg = *(const f32x4*)(cw + o) * gp + *(const f32x4*)(cw + D_FF2 + o) * gc + *(const f32x4*)(cw + 2 * D_FF2 + o) * gn + *(const f32x4*)(cb + o);
        const f32x4 cv = *(const f32x4*)(cw + D_FF + o) * vp + *(const f32x4*)(cw + D_FF2 + D_FF + o) * vc + *(const f32x4*)(cw + 2 * D_FF2 + D_FF + o) * vn + *(const f32x4*)(cb + D_FF + o);
        float oo[4];
#pragma unroll
        for (int j = 0; j < 4; ++j) oo[j] = cg[j] * __builtin_amdgcn_rcpf(1.f + __expf(-cg[j])) * cv[j];
        uint2 w; w.x = cvt_pk_bf16(oo[0], oo[1]); w.y = cvt_pk_bf16(oo[2], oo[3]);
        *(uint2*)(G + (size_t)row * D_FF + o) = w;
    }
}

__global__ void __launch_bounds__(NWAVES * 64, 2) mk_fwd(MkArgs a) {
    extern __shared__ __attribute__((aligned(16))) unsigned char lds_raw[];
    LAS unsigned char* lds = (LAS unsigned char*)lds_raw;
    const Params& p = a.p;
    const int tid = threadIdx.x, lane = tid & 63, wave = __builtin_amdgcn_readfirstlane(tid >> 6);
    const int G = gridDim.x; const int bx = blockIdx.x; const int vcu = (G % 8 == 0) ? (bx % 8) * (G / 8) + bx / 8 : bx;
    volatile LAS unsigned* MISC = (volatile LAS unsigned*)(lds + MISC_OFF);
    for (int u = tid; u < (LDS_BYTES - LDSCTL_OFF) / 4; u += NWAVES * 64) ((LAS unsigned*)(lds + LDSCTL_OFF))[u] = 0u;
    __syncthreads();
    unsigned* ctl = (unsigned*)(p.ws + WS_CTL);
    XcdBarrier bar; bar.bar = ctl + CW_BAR + a.li * XCD_BAR_WORDS; bar.x = 0; bar.st = nullptr;
    const bool multi = (a.ph_hi - a.ph_lo) > 1;
    if (multi) bar = xcd_barrier_post(ctl + CW_BAR + a.li * XCD_BAR_WORDS, MISC + 8);
    const int lo = a.ph_lo, hi = a.ph_hi;
#define IN(k) (lo <= (k) && (k) < hi)
#define SEAM(k) do { if (IN(k) && IN((k) + 1)) xcd_barrier(bar); } while (0)
    bf16_t* HBF = (bf16_t*)(p.ws + WS_HBF); bf16_t* PA = (bf16_t*)(p.ws + WS_A); bf16_t* MIX = (bf16_t*)(p.ws + WS_MIX);
    const float* MOD = (const float*)(p.ws + WS_MOD);
    const int sub = a.sub; const bool probe = a.li != 0;
    if (IN(PH_PRO_A)) { if (sub & 1) wconv_phase(p, lds, vcu, G); if (sub & 2) mod_phase(p, lds, vcu, G); if (sub & 4) filters_phase(p, lds, vcu, G); }
    SEAM(PH_PRO_A);
    if (IN(PH_PRO_B)) modred_phase(p, vcu, G);
    SEAM(PH_PRO_B);
    if (IN(PH_N0)) { if (sub & 1) norm0_phase(p, vcu, G); if (sub & 2) shw_phase(p, lds, vcu, G); }
    SEAM(PH_N0);
    unsigned long long* SS = (unsigned long long*)(p.ws + WS_SS); const float* SHW = (const float*)(p.ws + WS_SHW);
    for (int l = 0; l < DEPTH; ++l) {
        const int pb = PH_L0 + l * PHL_N; const bool last = (l == DEPTH - 1);
        const int nMt = last ? MLAT / BM : MTOT / BM;
        if (IN(pb + PHL_GEMM_IN)) {
            Gemm g{HBF, (const bf16_t*)(p.ws + WS_WIN) + (size_t)l * D_IN * DM, MTOT, D_IN, DM};
            RectOrder S; S.init(MLAT / BM, D_IN / BM, MCTX / BM, last ? (D_IN - COL_Q) / BM : D_IN / BM, MLAT / BM, last ? COL_Q / BM : 0, G, bx);
            EpiP E{PA, D_IN, SS + (size_t)(2 * l) * MTOT, SHW + (size_t)(2 * l) * 9 * D_FF2};
            gemm_phase<EpiP, RectOrder, true, true>(lds + RING_OFF, g, S, E);
        }
        SEAM(pb + PHL_GEMM_IN);
        if (IN(pb + PHL_PREP)) { if (sub & 1) prep_qk_phase(p, l, MTOT, vcu, G); if (sub & 2) prep_hy_phase(p, l, !last, lds, vcu, G); if (sub & 4) sgu_phase(p, l, last ? 128 : 144, lds, vcu, G); }
        SEAM(pb + PHL_PREP);
        if (IN(pb + PHL_MIX1)) { if (sub & 1) att::attn_phase(p, l, lds + RING_OFF, vcu, G, !last); if (sub & 2) hyc::conv_phase(p, l, lds + RING_OFF, vcu, G, !last); }
        SEAM(pb + PHL_MIX1);
        if (IN(pb + PHL_GEMM_OUT)) {
            Gemm g{MIX, (const bf16_t*)(p.ws + WS_WOUT) + (size_t)l * DM * DM, MTOT, DM, DM};
            RectOrder S; S.init(nMt, DM / BM, 0, 0, 0, 0, G, bx);
            EpiRes E{l == 0 ? p.in[0] : (const float*)p.out, l == 0 ? p.in[2] : (const float*)(p.ws + WS_CS), probe ? (float*)(p.ws + WS_A + 32 * MiB) : p.out, (float*)(p.ws + WS_CS), MOD + (size_t)l * 9 * 6144 + 2048,
                     HBF, p.in[29] + (size_t)l * DM, MOD + (size_t)l * 9 * 6144 + 4096, SS + (size_t)(2 * l + 1) * MTOT};
            gemm_phase<EpiRes, RectOrder, true, true>(lds + RING_OFF, g, S, E);
        }
        SEAM(pb + PHL_GEMM_OUT);
        if (IN(pb + PHL_GEMM_UP)) {
            Gemm g{HBF, (const bf16_t*)(p.ws + WS_WUP) + (size_t)l * D_FF2 * DM, MTOT, D_FF2, DM};
            RectOrder S; S.init(nMt, D_FF2 / BM, 0, 0, 0, 0, G, bx);
            EpiCG E{PA, (float*)(p.ws + WS_RAW), p.in[31] + (size_t)l * 3 * D_FF2, p.in[32] + (size_t)l * D_FF2, SS + (size_t)(2 * l + 1) * MTOT, SHW + (size_t)(2 * l + 1) * 9 * D_FF2};
            gemm_phase<EpiCG, RectOrder, true, true>(lds + RING_OFF, g, S, E);
        }
        SEAM(pb + PHL_GEMM_UP);
        if (IN(pb + PHL_GEMM_DOWN)) {
            Gemm g{PA, (const bf16_t*)(p.ws + WS_WDN) + (size_t)l * DM * D_FF, MTOT, DM, D_FF};
            RectOrder S; S.init(nMt, DM / BM, 0, 0, 0, 0, G, bx);
            { Unit fu; for (int i = 0; S.next(i, fu); ++i) fixup_phase(p, l, fu.pm * 4, 4, wave, NWAVES, lane); }
            asm volatile("s_waitcnt vmcnt(0)" ::: "memory"); __syncthreads();
            EpiRes E{(const float*)p.out, (const float*)(p.ws + WS_CS), probe ? (float*)(p.ws + WS_A + 32 * MiB) : p.out, (float*)(p.ws + WS_CS), MOD + (size_t)l * 9 * 6144 + 5120,
                     last ? (bf16_t*)nullptr : HBF, p.in[6] + (size_t)(l + 1) * DM, MOD + (size_t)(l + 1) * 9 * 6144 + 1024, SS + (size_t)(2 * l + 2) * MTOT};
            gemm_phase<EpiRes, RectOrder, true, true>(lds + RING_OFF, g, S, E);
        }
        SEAM(pb + PHL_GEMM_DOWN);
    }
#undef IN
#undef SEAM
}
}

extern "C" void kernel_launch(void* const* d_in, const int* in_sizes, int n_in, void* d_out, int out_size, void* d_ws, size_t ws_size, hipStream_t stream) {
    static int ok = 0;
    if (ok == 0) {
        if (n_in != 34 || in_sizes[0] != MLAT * DM || out_size != MLAT * DM || ws_size < WS_END) {
            fprintf(stderr, "kernel_launch: unexpected shapes n_in %d in0 %d out %d ws %zu\n", n_in, n_in > 0 ? in_sizes[0] : -1, out_size, ws_size); ok = -1; return; }
        if (hipFuncSetAttribute((const void*)mk_fwd, hipFuncAttributeMaxDynamicSharedMemorySize, LDS_BYTES) != hipSuccess) { fprintf(stderr, "kernel_launch: LDS attribute failed\n"); ok = -1; return; }
        ok = 1;
    }
    if (ok < 0) return;
    (void)hipMemsetAsync((char*)d_ws + WS_CTL, 0, CTL_BYTES, stream);
    MkArgs a{};
    for (int i = 0; i < 34; ++i) a.p.in[i] = (const float*)d_in[i];
    a.p.out = (float*)d_out; a.p.ws = (unsigned char*)d_ws;
#if MK_PER_PHASE
    for (int ph = 0; ph < PH_TOTAL; ++ph) { a.ph_lo = ph; a.ph_hi = ph + 1; a.li = 0; a.sub = 0xff; hipLaunchKernelGGL(mk_fwd, dim3(256), dim3(NWAVES * 64), LDS_BYTES, stream, a); }
#else
    a.ph_lo = 0; a.ph_hi = PH_TOTAL; a.li = 0; a.sub = 0xff;
    hipLaunchKernelGGL(mk_fwd, dim3(256), dim3(NWAVES * 64), LDS_BYTES, stream, a);
#endif
#if PROBE_PH >= 0
    for (int r = 0; r < PROBE_REP; ++r) { a.ph_lo = PROBE_PH; a.ph_hi = PROBE_PH + 1; a.li = 1; a.sub = PROBE_SUB; hipLaunchKernelGGL(mk_fwd, dim3(256), dim3(NWAVES * 64), LDS_BYTES, stream, a); }
#endif
}
```

```cpp
#include <hip/hip_runtime.h>
#include <hip/hip_bf16.h>
#include <cstdint>
#include <cstdio>

#ifndef MK_PER_PHASE
#define MK_PER_PHASE 0
#endif
#ifndef PROBE_PH
#define PROBE_PH -1
#endif
#ifndef PROBE_REP
#define PROBE_REP 4
#endif
#ifndef PROBE_SUB
#define PROBE_SUB 0xff
#endif
namespace {
constexpr int DM = 1024, NB = 8, SEQ = 2048, DEPTH = 2, CTXL = 256;
constexpr int MLAT = NB * SEQ, MCTX = NB * CTXL, MTOT = MLAT + MCTX;
constexpr int D_HY = 256, D_SG = 256, NH = 4, QKD = 64, VD = 128;
constexpr int IN_A = 768, IN_B = 512, D_IN = 2816;
constexpr int COL_Q = 1280, COL_K = 1792, COL_V = 2304;
constexpr int D_FF = 2816, D_FF2 = 5632;
constexpr int HY_EMB = 33, HY_FFN = 64;
constexpr float EPS = 1e-6f;
constexpr float LOG2E = 1.4426950408889634f;
constexpr float QSCALE = 0.125f * LOG2E;
constexpr int FL = 2 * SEQ, FLC = 2 * CTXL;

constexpr size_t MiB = 1u << 20;
constexpr size_t WS_CTL = 0, CTL_BYTES = 2 * MiB;
constexpr size_t WS_MOD = 64 * 1024;
constexpr size_t WS_SS = 1 * MiB;
constexpr size_t WS_WSF = 640 * 1024;
constexpr size_t WS_SHB = 2 * MiB + 896 * 1024;
constexpr size_t WS_SHW = 2 * MiB;
constexpr size_t WS_WIN = 3 * MiB, WS_WOUT = 14 * MiB, WS_WUP = 18 * MiB, WS_WDN = 40 * MiB;
constexpr size_t WS_CS = 51 * MiB;
constexpr size_t WS_FILT = 59 * MiB;
constexpr size_t WS_FILTC = 67 * MiB;
constexpr size_t WS_ROPE = 67 * MiB + 512 * 1024;
constexpr size_t WS_A = 68 * MiB;
constexpr size_t WS_B = 167 * MiB;
constexpr size_t WS_HBF = WS_B;
constexpr size_t WS_HYT = WS_B;
constexpr size_t HYT_LAT_ELEMS = (size_t)D_HY * NB * SEQ, HYT_CTX_ELEMS = (size_t)D_HY * NB * CTXL;
constexpr size_t WS_HYTC = WS_HYT + 4 * HYT_LAT_ELEMS * 2;
constexpr size_t WS_MIX = WS_B + 36 * MiB;
constexpr size_t WS_UCH = WS_B + 36 * MiB;
constexpr size_t WS_END = 239 * MiB;
constexpr float SS_SCALE = 16777216.f, SS_INV = 1.f / (16777216.f * 1024.f);

typedef unsigned short bf16_t;
typedef float f32x4 __attribute__((ext_vector_type(4)));
typedef short bf16x8 __attribute__((ext_vector_type(8)));
typedef unsigned u32x4 __attribute__((ext_vector_type(4)));

__device__ __forceinline__ unsigned f2bf(float f) { unsigned u = __builtin_bit_cast(unsigned, f); return (u + 0x7fffu + ((u >> 16) & 1u)) >> 16; }
__device__ __forceinline__ unsigned pk2(float lo, float hi) { return f2bf(lo) | (f2bf(hi) << 16); }
__device__ __forceinline__ float bf2f(unsigned short h) { return __builtin_bit_cast(float, (unsigned)h << 16); }
__device__ __forceinline__ float bflo(unsigned w) { return __builtin_bit_cast(float, w << 16); }
__device__ __forceinline__ float bfhi(unsigned w) { return __builtin_bit_cast(float, w & 0xffff0000u); }
__device__ __forceinline__ float silu_f(float x) { return x / (1.f + __expf(-x)); }
__device__ __forceinline__ float gelu_tanh(float x) { const float u2 = 1.5957691216057308f * (x + 0.044715f * x * x * x); return x * __builtin_amdgcn_rcpf(1.f + __expf(-u2)); }

struct Params {
    const float* in[34];
    float* out;
    unsigned char* ws;
};

__device__ __forceinline__ float modv(const Params& p, int l, int r, int idx) {
    const float* acc = (const float*)(p.ws + WS_MOD);
    return acc[((size_t)l * 9 + r) * 6144 + idx];
}

constexpr int NWAVES = 8;

#define PG8_LAS __attribute__((address_space(3)))
constexpr int BM = 256, BK = 64, HALF = 128, HTB = HALF * BK * 2  , STAGE_BYTES = 8 * HTB, NXCD = 8, WGM = 8;

__host__ __device__ __forceinline__ int lds_byte(int r, int c) { const int st = (r >> 4) * 2 + (c >> 5), rr = r & 15, cc = c & 31, ob = rr * 64 + cc * 2; return st * 1024 + (ob ^ (((ob >> 9) & 1) << 5)); }
__host__ __device__ __forceinline__ void stage_rc(int b, int& R, int& C) { const int st = b / 1024, sb = b % 1024, swz = sb ^ (((sb >> 9) & 1) << 5); R = (st >> 1) * 16 + swz / 64; C = (st & 1) * 32 + (swz % 64) / 2; }
__host__ __device__ __forceinline__ int perm32(int rho) { const int n = rho >> 4, i = rho & 15; return 8 * (i >> 2) + 4 * n + (i & 3); }

struct Unit { int pm, pn; };
struct Gemm { const bf16_t* A; const bf16_t* Bt; int M, N, K; };


struct RectOrder {
    int nM1, nN1, n1, nM2, nN2, n2, pm2off, pn2off, G, c;
    __device__ void init(int nM1_, int nN1_, int nM2_, int nN2_, int pm2off_, int pn2off_, int G_, int c_) {
        nM1 = nM1_; nN1 = nN1_; n1 = nM1_ * nN1_; nM2 = nM2_; nN2 = nN2_; n2 = nM2_ * nN2_; pm2off = pm2off_; pn2off = pn2off_; G = G_; c = c_; }
    __device__ __forceinline__ static void map(int wgid, int nM, int nN, int nwg, Unit& u) {
        { const int q = nwg / NXCD, r = nwg % NXCD, xcd = wgid % NXCD, off = wgid / NXCD; wgid = (xcd < r ? xcd * (q + 1) : r * (q + 1) + (xcd - r) * q) + off; }
        const int nig = WGM * nN, gid = wgid / nig, fm = gid * WGM, gsz = (nM - fm) < WGM ? (nM - fm) : WGM;
        u.pm = fm + ((wgid % nig) % gsz); u.pn = (wgid % nig) / gsz; }
    __device__ bool next(int i, Unit& u) const {
        long L = (long)i * G + c;
        if (L < n1) { map((int)L, nM1, nN1, n1, u); return true; }
        L -= n1; if (L < n2) { map((int)L, nM2, nN2, n2, u); u.pm += pm2off; u.pn += pn2off; return true; }
        return false; }
    __device__ __forceinline__ void a_ready(const Unit&) const {}
    __device__ __forceinline__ void done(const Unit&) const {}
};
__device__ __forceinline__ unsigned cvt_pk_bf16(float lo, float hi) { unsigned r; asm volatile("v_cvt_pk_bf16_f32 %0, %1, %2" : "=v"(r) : "v"(lo), "v"(hi)); return r; }

struct EpiP {
    static constexpr bool PERM = true, AFTER_DRAIN = false;
    bf16_t* O; int ldc; const unsigned long long* SSi; const float* shw;
    __device__ __forceinline__ void operator()(const f32x4 (&acc)[2][2][4][2], const Unit& u, int wr, int wc, int fr, int fq) const {
        const int row0 = u.pm * BM + wr * 64 + fr, col0 = u.pn * BM + wc * 32 + 8 * fq;
        const float* sp = shw + (size_t)(u.pm < MLAT / BM ? (u.pm >> 3) : 8) * D_FF2 + col0;
        f32x4 sv[2][2];
#pragma unroll
        for (int bj = 0; bj < 2; ++bj)
#pragma unroll
            for (int n = 0; n < 2; ++n) sv[bj][n] = *(const f32x4*)(sp + bj * HALF + 4 * n);
#pragma unroll
        for (int ai = 0; ai < 2; ++ai)
#pragma unroll
            for (int m = 0; m < 4; ++m) { const int row = row0 + ai * HALF + m * 16; bf16_t* rowp = O + (size_t)row * ldc + col0;
                const float rs = rsqrtf((float)SSi[row] * SS_INV + EPS);
#pragma unroll
                for (int bj = 0; bj < 2; ++bj) { const f32x4 v0 = acc[ai][bj][m][0] * rs + sv[bj][0], v1 = acc[ai][bj][m][1] * rs + sv[bj][1];
                    u32x4 w; w.x = cvt_pk_bf16(v0[0], v0[1]); w.y = cvt_pk_bf16(v0[2], v0[3]); w.z = cvt_pk_bf16(v1[0], v1[1]); w.w = cvt_pk_bf16(v1[2], v1[3]);
                    *(u32x4*)(rowp + bj * HALF) = w; } }
    }
};
struct EpiRes {
    static constexpr bool PERM = false, AFTER_DRAIN = false;
    const float* base_lat; const float* base_ctx; float* out_lat; float* out_ctx; const float* gate;
    bf16_t* Hn; const float* ng; const float* scp; unsigned long long* SSo;
    __device__ __forceinline__ void operator()(const f32x4 (&acc)[2][2][4][2], const Unit& u, int wr, int wc, int fr, int fq) const {
        const bool lat = u.pm < MLAT / BM;
        const float* base = lat ? base_lat : base_ctx; float* out = lat ? out_lat : out_ctx;
        const int rb = (lat ? u.pm * BM : u.pm * BM - MLAT) + wr * 64 + fr, col0 = u.pn * BM + wc * 32 + 4 * fq;
        const int mr = lat ? (u.pm >> 3) : 8;
        const float* gp = gate + (size_t)mr * 6144 + col0;
        f32x4 gv[2][2], gs[2][2];
#pragma unroll
        for (int bj = 0; bj < 2; ++bj)
#pragma unroll
            for (int n = 0; n < 2; ++n) { gv[bj][n] = *(const f32x4*)(gp + bj * HALF + n * 16);
                if (Hn) gs[bj][n] = *(const f32x4*)(ng + col0 + bj * HALF + n * 16) * (1.f + *(const f32x4*)(scp + (size_t)mr * 6144 + col0 + bj * HALF + n * 16)); }
#pragma unroll
        for (int ai = 0; ai < 2; ++ai)
#pragma unroll
            for (int m = 0; m < 4; ++m) { const size_t off = (size_t)(rb + ai * HALF + m * 16) * DM + col0;
                const size_t grow = (size_t)(u.pm * BM + wr * 64 + fr + ai * HALF + m * 16);
                float ss = 0.f;
#pragma unroll
                for (int bj = 0; bj < 2; ++bj)
#pragma unroll
                    for (int n = 0; n < 2; ++n) { const f32x4 bs = *(const f32x4*)(base + off + bj * HALF + n * 16);
                        const f32x4 o = bs + gv[bj][n] * acc[ai][bj][m][n];
                        *(f32x4*)(out + off + bj * HALF + n * 16) = o;
                        if (Hn) { ss += (o[0] * o[0] + o[1] * o[1]) + (o[2] * o[2] + o[3] * o[3]); const f32x4 a = o * gs[bj][n];
                            uint2 w; w.x = cvt_pk_bf16(a[0], a[1]); w.y = cvt_pk_bf16(a[2], a[3]); *(uint2*)(Hn + grow * DM + col0 + bj * HALF + n * 16) = w; } }
                if (Hn) { ss += __shfl_xor(ss, 16); ss += __shfl_xor(ss, 32);
                    if (fq == 0) atomicAdd(SSo + grow, (unsigned long long)(ss * SS_SCALE + 0.5f)); } }
    }
};
__device__ __forceinline__ float lane_prev16(float x, int) { return __builtin_bit_cast(float, __builtin_amdgcn_update_dpp(0, __builtin_bit_cast(int, x), 0x121, 0xf, 0xf, false)); }
__device__ __forceinline__ float lane_next16(float x, int) { return __builtin_bit_cast(float, __builtin_amdgcn_update_dpp(0, __builtin_bit_cast(int, x), 0x12f, 0xf, 0xf, false)); }
struct EpiCG {
    static constexpr bool PERM = true, AFTER_DRAIN = false;
    bf16_t* G; float* RAW; const float* cw; const float* cb; const unsigned long long* SSi; const float* shw;
    __device__ __forceinline__ void operator()(const f32x4 (&acc)[2][2][4][2], const Unit& u, int wr, int wc, int fr, int fq) const {
        const int lane = fq * 16 + fr;
        float rs[2][4];
#pragma unroll
        for (int ai = 0; ai < 2; ++ai)
#pragma unroll
            for (int m = 0; m < 4; ++m) rs[ai][m] = rsqrtf((float)SSi[u.pm * BM + ai * HALF + wr * 64 + m * 16 + fr] * SS_INV + EPS);
        const float* sp = shw + (size_t)(u.pm < MLAT / BM ? (u.pm >> 3) : 8) * D_FF2;
#pragma unroll
        for (int n = 0; n < 2; ++n) {
            const int oc = u.pn * HALF + wc * 32 + 8 * fq + 4 * n;
            const int rg = u.pn * BM + wc * 32 + 8 * fq + 4 * n;
            const f32x4 w0g = *(const f32x4*)(cw + oc), w1g = *(const f32x4*)(cw + D_FF2 + oc), w2g = *(const f32x4*)(cw + 2 * D_FF2 + oc), bg = *(const f32x4*)(cb + oc);
            const f32x4 w0v = *(const f32x4*)(cw + D_FF + oc), w1v = *(const f32x4*)(cw + D_FF2 + D_FF + oc), w2v = *(const f32x4*)(cw + 2 * D_FF2 + D_FF + oc), bv = *(const f32x4*)(cb + D_FF + oc);
            const f32x4 shg = *(const f32x4*)(sp + rg), shv = *(const f32x4*)(sp + rg + HALF);
#pragma unroll
            for (int ai = 0; ai < 2; ++ai) {
                const int rowc = u.pm * BM + ai * HALF + wr * 64;
                const int chunk = rowc >> 6;
                f32x4 sg[4], sv[4];
#pragma unroll
                for (int m = 0; m < 4; ++m) { sg[m] = acc[ai][0][m][n] * rs[ai][m] + shg; sv[m] = acc[ai][1][m][n] * rs[ai][m] + shv; }
#pragma unroll
                for (int m = 0; m < 4; ++m) {
                    const f32x4 gc = sg[m], vc = sv[m];
                    const f32x4 gpm = sg[m > 0 ? m - 1 : 0], vpm = sv[m > 0 ? m - 1 : 0];
                    const f32x4 gnm = sg[m < 3 ? m + 1 : 3], vnm = sv[m < 3 ? m + 1 : 3];
                    f32x4 gp, gn, vp, vn;
#pragma unroll
                    for (int j = 0; j < 4; ++j) {
                        gp[j] = lane_prev16(fr == 15 ? gpm[j] : gc[j], lane); gn[j] = lane_next16(fr == 0 ? gnm[j] : gc[j], lane);
                        vp[j] = lane_prev16(fr == 15 ? vpm[j] : vc[j], lane); vn[j] = lane_next16(fr == 0 ? vnm[j] : vc[j], lane); }
                    const f32x4 cg = w0g * gp + w1g * gc + w2g * gn + bg, cv = w0v * vp + w1v * vc + w2v * vn + bv;
                    float o[4];
#pragma unroll
                    for (int j = 0; j < 4; ++j) o[j] = cg[j] * __builtin_amdgcn_rcpf(1.f + __expf(-cg[j])) * cv[j];
                    uint2 w; w.x = cvt_pk_bf16(o[0], o[1]); w.y = cvt_pk_bf16(o[2], o[3]);
                    *(uint2*)(G + (size_t)(rowc + m * 16 + fr) * D_FF + oc) = w;
                    if (m == 0 && fr < 2) { float* r = RAW + ((size_t)chunk * 4 + fr) * D_FF2 + rg; *(f32x4*)r = gc; *(f32x4*)(r + HALF) = vc; }
                    if (m == 3 && fr >= 14) { float* r = RAW + ((size_t)chunk * 4 + (fr - 12)) * D_FF2 + rg; *(f32x4*)r = gc; *(f32x4*)(r + HALF) = vc; }
                }
            }
        }
    }
};

template <class Epi, class Sched, bool ALIGN_EPI = false, bool SP2 = false>
__device__ __forceinline__ void gemm_phase(PG8_LAS unsigned char* lds, const Gemm g, const Sched& S, const Epi& E) {
    int tid_o = threadIdx.x; asm volatile("" : "+v"(tid_o));
    const int tid = tid_o, wid = __builtin_amdgcn_readfirstlane(tid >> 6), lane = tid & 63, wr = wid >> 2, wc = wid & 3, fr = lane & 15, fq = lane >> 4;
    const int K = g.K, nt = K / BK;
    unsigned voffA[2], voffB[2];
#pragma unroll
    for (int i = 0; i < 2; ++i) { int R, C; stage_rc(tid * 16 + i * 8192, R, C); const int Rb = Epi::PERM ? ((R & ~31) + perm32(R & 31)) : R;
        voffA[i] = (unsigned)(R * K + C) * 2u; voffB[i] = (unsigned)(Rb * K + C) * 2u; }
    const size_t kstep = (size_t)(BK * 2);
    const size_t hstep = (size_t)HALF * K * 2;
    const size_t tstep = 2 * hstep;
    const unsigned ldsw = (unsigned)wid * 1024u;
    const int aoff = lds_byte(wr * 64 + fr, fq * 8), boff = lds_byte(wc * 32 + fr, fq * 8);
#define PG8_SA(b, h) (((b) * 2 + (h)) * HTB)
#define PG8_SB(b, h) ((4 + (b) * 2 + (h)) * HTB)
#define PG8_STAGE(bufoff, gbase, voff) do { _Pragma("unroll") for (int _i = 0; _i < 2; ++_i) \
        __builtin_amdgcn_global_load_lds((const unsigned*)((const char*)(gbase) + (voff)[_i]), (PG8_LAS unsigned*)(lds + (bufoff) + ldsw + _i * 8192), 16, 0, 0); } while (0)
#define PG8_LDA(dst, b, h) do { _Pragma("unroll") for (int m = 0; m < 4; ++m) _Pragma("unroll") for (int k = 0; k < 2; ++k) dst[m][k] = *(const PG8_LAS bf16x8*)(lds + PG8_SA(b, h) + aoff + m * 2048 + k * 1024); } while (0)
#define PG8_LDB(dst, b, h) do { _Pragma("unroll") for (int n = 0; n < 2; ++n) _Pragma("unroll") for (int k = 0; k < 2; ++k) dst[n][k] = *(const PG8_LAS bf16x8*)(lds + PG8_SB(b, h) + boff + n * 2048 + k * 1024); } while (0)
#define PG8_MMA(ai, bj, At, Bt) do { __builtin_amdgcn_s_setprio(1); _Pragma("unroll") for (int m = 0; m < 4; ++m) _Pragma("unroll") for (int n = 0; n < 2; ++n) _Pragma("unroll") for (int k = 0; k < 2; ++k) \
        acc[ai][bj][m][n] = __builtin_amdgcn_mfma_f32_16x16x32_bf16(Bt[n][k], At[m][k], acc[ai][bj][m][n], 0, 0, 0); __builtin_amdgcn_s_setprio(0); } while (0)
#define PG8_WAIT_V(n) asm volatile("s_waitcnt vmcnt(" #n ")" ::: "memory")
#define PG8_WAIT_L(n) asm volatile("s_waitcnt lgkmcnt(" #n ")" ::: "memory")
#define PG8_BAR __builtin_amdgcn_s_barrier()
#define PG8_SCHED __builtin_amdgcn_sched_barrier(0)
    Unit cur, nxt; int ui = 0;
    if (!S.next(0, cur)) return;
    f32x4 acc[2][2][4][2];
#pragma unroll
    for (int a = 0; a < 2; ++a)
#pragma unroll
        for (int b = 0; b < 2; ++b)
#pragma unroll
            for (int m = 0; m < 4; ++m)
#pragma unroll
                for (int n = 0; n < 2; ++n) acc[a][b][m][n] = (f32x4){0.f, 0.f, 0.f, 0.f};
    bf16x8 At[4][2], B0[2][2], B1[2][2];
    const char* cA = (const char*)g.A + (size_t)cur.pm * tstep; const char* cB = (const char*)g.Bt + (size_t)cur.pn * tstep;
    S.a_ready(cur);
    if constexpr (SP2) {
        PG8_STAGE(PG8_SB(0, 0), cB, voffB); PG8_STAGE(PG8_SB(0, 1), cB + hstep, voffB); PG8_STAGE(PG8_SA(0, 0), cA, voffA); PG8_STAGE(PG8_SA(0, 1), cA + hstep, voffA);
        if (wr == 1) PG8_BAR;
        PG8_WAIT_V(2); PG8_BAR;
        PG8_STAGE(PG8_SB(1, 0), cB + kstep, voffB); PG8_STAGE(PG8_SA(1, 0), cA + kstep, voffA); PG8_STAGE(PG8_SB(1, 1), cB + hstep + kstep, voffB);
        PG8_WAIT_V(6); PG8_BAR;
    } else {
        PG8_STAGE(PG8_SB(0, 0), cB, voffB); PG8_STAGE(PG8_SA(0, 0), cA, voffA); PG8_STAGE(PG8_SB(0, 1), cB + hstep, voffB); PG8_STAGE(PG8_SA(0, 1), cA + hstep, voffA);
        if (wr == 1) PG8_BAR;
        PG8_WAIT_V(4); PG8_BAR;
        PG8_STAGE(PG8_SB(1, 0), cB + kstep, voffB); PG8_STAGE(PG8_SA(1, 0), cA + kstep, voffA); PG8_STAGE(PG8_SB(1, 1), cB + hstep + kstep, voffB);
        PG8_WAIT_V(6); PG8_BAR;
    }
    for (;;) {
        const bool has_next = S.next(ui + 1, nxt);
        const char* nA = has_next ? (const char*)g.A + (size_t)nxt.pm * tstep : cA; const char* nB = has_next ? (const char*)g.Bt + (size_t)nxt.pn * tstep : cB;
        for (int t = 0; t < nt; t += 2) {
            const bool last = (t == nt - 2);
            const char* a1 = cA + (size_t)(t + 1) * kstep;
            const char* a2 = last ? nA : cA + (size_t)(t + 2) * kstep; const char* b2 = last ? nB : cB + (size_t)(t + 2) * kstep;
            const char* a3 = a2 + kstep; const char* b3 = b2 + kstep;
            if (last && has_next) S.a_ready(nxt);
            if constexpr (SP2) {
            PG8_LDB(B0, 0, 0); PG8_LDB(B1, 0, 1); PG8_SCHED; PG8_LDA(At, 0, 0); PG8_STAGE(PG8_SA(1, 1), a1 + hstep, voffA);
            PG8_WAIT_V(8); PG8_WAIT_L(0); PG8_BAR; PG8_MMA(0, 0, At, B0); PG8_MMA(0, 1, At, B1); PG8_BAR; PG8_SCHED;
            PG8_LDA(At, 0, 1); PG8_STAGE(PG8_SB(0, 0), b2, voffB); PG8_STAGE(PG8_SB(0, 1), b2 + hstep, voffB); PG8_STAGE(PG8_SA(0, 0), a2, voffA);
            PG8_WAIT_V(8); PG8_WAIT_L(0); PG8_BAR; PG8_MMA(1, 0, At, B0); PG8_MMA(1, 1, At, B1); PG8_BAR; PG8_SCHED;
            PG8_LDB(B0, 1, 0); PG8_LDB(B1, 1, 1); PG8_SCHED; PG8_LDA(At, 1, 0); PG8_STAGE(PG8_SA(0, 1), a2 + hstep, voffA);
            PG8_WAIT_V(8); PG8_WAIT_L(0); PG8_BAR; PG8_MMA(0, 0, At, B0); PG8_MMA(0, 1, At, B1); PG8_BAR; PG8_SCHED;
            PG8_LDA(At, 1, 1); PG8_STAGE(PG8_SB(1, 0), b3, voffB); PG8_STAGE(PG8_SB(1, 1), b3 + hstep, voffB); PG8_STAGE(PG8_SA(1, 0), a3, voffA);
            PG8_WAIT_V(8); PG8_WAIT_L(0); PG8_BAR; PG8_MMA(1, 0, At, B0); PG8_MMA(1, 1, At, B1); PG8_BAR; PG8_SCHED;
            } else {
            PG8_LDB(B0, 0, 0); PG8_SCHED; PG8_LDA(At, 0, 0); PG8_STAGE(PG8_SA(1, 1), a1 + hstep, voffA);
            PG8_WAIT_L(8); PG8_BAR; PG8_WAIT_L(0); PG8_MMA(0, 0, At, B0); PG8_BAR; PG8_SCHED;
            PG8_LDB(B1, 0, 1); PG8_STAGE(PG8_SB(0, 0), b2, voffB);
            PG8_BAR; PG8_WAIT_L(0); PG8_MMA(0, 1, At, B1); PG8_BAR;
            PG8_LDA(At, 0, 1); PG8_STAGE(PG8_SA(0, 0), a2, voffA);
            PG8_BAR; PG8_WAIT_L(0); PG8_MMA(1, 0, At, B0); PG8_BAR; PG8_SCHED;
            PG8_STAGE(PG8_SB(0, 1), b2 + hstep, voffB);
            PG8_WAIT_V(6); PG8_BAR; PG8_MMA(1, 1, At, B1); PG8_BAR;
            PG8_LDB(B0, 1, 0); PG8_SCHED; PG8_LDA(At, 1, 0); PG8_STAGE(PG8_SA(0, 1), a2 + hstep, voffA);
            PG8_WAIT_L(8); PG8_BAR; PG8_WAIT_L(0); PG8_MMA(0, 0, At, B0); PG8_BAR; PG8_SCHED;
            PG8_LDB(B1, 1, 1); PG8_STAGE(PG8_SB(1, 0), b3, voffB);
            PG8_BAR; PG8_WAIT_L(0); PG8_MMA(0, 1, At, B1); PG8_BAR;
            PG8_LDA(At, 1, 1); PG8_STAGE(PG8_SA(1, 0), a3, voffA);
            PG8_BAR; PG8_WAIT_L(0); PG8_MMA(1, 0, At, B0); PG8_BAR; PG8_SCHED;
            PG8_STAGE(PG8_SB(1, 1), b3 + hstep, voffB);
            PG8_WAIT_V(6); PG8_BAR; PG8_MMA(1, 1, At, B1); PG8_BAR;
            }
        }
        if constexpr (ALIGN_EPI) { if (wr == 0) PG8_BAR; }
        if constexpr (!Epi::AFTER_DRAIN) { E(acc, cur, wr, wc, fr, fq); S.done(cur); }
        if (!has_next) break;
#pragma unroll
        for (int a = 0; a < 2; ++a)
#pragma unroll
            for (int b = 0; b < 2; ++b)
#pragma unroll
                for (int m = 0; m < 4; ++m)
#pragma unroll
                    for (int n = 0; n < 2; ++n) acc[a][b][m][n] = (f32x4){0.f, 0.f, 0.f, 0.f};
        cur = nxt; cA = nA; cB = nB; ++ui;
        if constexpr (ALIGN_EPI) { if (wr == 1) PG8_BAR; }
    }
    PG8_WAIT_V(0);
    if constexpr (!ALIGN_EPI) { if (wr == 0) PG8_BAR; }
    PG8_BAR;
    if constexpr (Epi::AFTER_DRAIN) { E.fused(acc, cur, wr, wc, fr, fq, lds, wid, lane); S.done(cur); }
#undef PG8_SA
#undef PG8_SB
#undef PG8_STAGE
#undef PG8_LDA
#undef PG8_LDB
#undef PG8_MMA
#undef PG8_WAIT_V
#undef PG8_WAIT_L
#undef PG8_BAR
#undef PG8_SCHED
}

#define GAS __attribute__((address_space(1)))
#define LAS __attribute__((address_space(3)))
typedef unsigned v4u __attribute__((ext_vector_type(4)));
typedef GAS unsigned gu32;
typedef GAS unsigned long long gu64;
#define RLX_AGENT __ATOMIC_RELAXED, __HIP_MEMORY_SCOPE_AGENT
#define LDS_WAIT() asm volatile("s_waitcnt lgkmcnt(0)" ::: "memory")
#define VM_WAIT() asm volatile("s_waitcnt vmcnt(0)" ::: "memory")
__device__ __forceinline__ unsigned long long rt() { return __builtin_amdgcn_s_memrealtime(); }

#define XB_TMO      128
#define XB_XCNT(j)  (256  + 64 * (j))
#define XB_XSUB(j)  (1280 + 64 * (j))
#define XB_XGEN(j)  (2304 + 64 * (j))
#define XB_TOP      3328
#define XB_TOPGEN   3392
#define XCD_BAR_WORDS 3456
#define XB_SPIN_CAP (1u << 18)

__device__ __forceinline__ unsigned xb_ld(unsigned* p)              { return __hip_atomic_load(p, __ATOMIC_RELAXED, __HIP_MEMORY_SCOPE_AGENT); }
__device__ __forceinline__ unsigned xb_add(unsigned* p, unsigned v) { return __hip_atomic_fetch_add(p, v, __ATOMIC_RELAXED, __HIP_MEMORY_SCOPE_AGENT); }
__device__ __forceinline__ unsigned xb_xcc_id() { return (unsigned)__builtin_amdgcn_s_getreg((3 << 11) | 20) & 0xFu; }
#define XB_SPIN(cond, bar) do { unsigned _sp = 0; while (cond) { __builtin_amdgcn_s_sleep(1); \
    if ((++_sp & 255u) == 0u) { if (xb_ld(&(bar)[XB_TMO])) break; if (_sp > XB_SPIN_CAP) { atomicAdd(&(bar)[XB_TMO], 1u); break; } } } } while (0)

struct XcdBarrier {
    unsigned* bar; unsigned x;
    volatile LAS unsigned* st;
};

__device__ __forceinline__ XcdBarrier xcd_barrier_post(unsigned* bar, volatile LAS unsigned* st) {
    XcdBarrier b; b.bar = bar; b.x = xb_xcc_id(); b.st = st;
    if (threadIdx.x == 0) (void)xb_add(&bar[XB_XCNT(b.x)], 1u);
    return b;
}
__device__ __forceinline__ void xcd_barrier_complete(unsigned* bar, unsigned x, unsigned& nloc, unsigned& nx) {
    const unsigned G = gridDim.x * gridDim.y * gridDim.z;
    unsigned sum, cnt, mine, sp = 0u;
    for (;;) {
        sum = 0u; cnt = 0u; mine = 0u;
#pragma unroll
        for (unsigned j = 0; j < 16; ++j) { const unsigned c = xb_ld(&bar[XB_XCNT(j)]); sum += c; cnt += (c > 0u) ? 1u : 0u; mine = (j == x) ? c : mine; }
        if (sum == G) break;
        __builtin_amdgcn_s_sleep(1);
        if ((++sp & 255u) == 0u) { if (xb_ld(&bar[XB_TMO])) break; if (sp > XB_SPIN_CAP) { atomicAdd(&bar[XB_TMO], 1u); break; } }
    }
    nloc = mine > 0u ? mine : 1u; nx = cnt > 0u ? cnt : 1u;
}

__device__ __forceinline__ void xcd_barrier(const XcdBarrier& b) {
    asm volatile("s_waitcnt vmcnt(0)" ::: "memory");
    __syncthreads();
    if (threadIdx.x == 0) {
        unsigned* bar = b.bar;
        __builtin_amdgcn_s_waitcnt(0);
        unsigned nloc = b.st[0], nx = b.st[1];
        if (nloc == 0u) { xcd_barrier_complete(bar, b.x, nloc, nx); b.st[0] = nloc; b.st[1] = nx; }
        const unsigned old = xb_add(&bar[XB_XSUB(b.x)], 1u);
        const unsigned gen = old / nloc;
        if (old + 1u == (gen + 1u) * nloc) {
            __builtin_amdgcn_fence(__ATOMIC_RELEASE, "agent");
            asm volatile("s_waitcnt vmcnt(0)" ::: "memory");
            const unsigned og = xb_add(&bar[XB_TOP], 1u);
            const unsigned tg = og / nx;
            if (og + 1u == (tg + 1u) * nx) xb_add(&bar[XB_TOPGEN], 1u);
            else XB_SPIN(xb_ld(&bar[XB_TOPGEN]) == tg, bar);
            __builtin_amdgcn_fence(__ATOMIC_ACQUIRE, "agent");
            xb_add(&bar[XB_XGEN(b.x)], 1u);
            asm volatile("s_waitcnt vmcnt(0)" ::: "memory");
        } else {
            XB_SPIN(xb_ld(&bar[XB_XGEN(b.x)]) == gen, bar);
            __builtin_amdgcn_fence(__ATOMIC_ACQUIRE, "agent");
            asm volatile("s_waitcnt vmcnt(0)" ::: "memory");
        }
    }
    __syncthreads();
}

typedef LAS float lfloat;
__device__ __forceinline__ void transpose_item_l(const float* W, int K, int N, bf16_t* WT, bool upperm, lfloat* scr, int item, int lane) {
    const int nblk = N / 32, kb = item / nblk, nb = item % nblk, k0 = 64 * kb, n0 = 32 * nb;
    int r0 = n0;
    if (upperm) { r0 = (n0 < D_FF) ? (256 * (n0 / 128) + (n0 % 128)) : (256 * ((n0 - D_FF) / 128) + 128 + ((n0 - D_FF) % 128)); }
#pragma unroll 8
    for (int i = 0; i < 32; ++i) { const int kk = 2 * i + (lane >> 5); scr[kk * 33 + (lane & 31)] = W[(size_t)(k0 + kk) * N + n0 + (lane & 31)]; }
    asm volatile("s_waitcnt lgkmcnt(0)" ::: "memory");
    const int c = lane & 7;
#pragma unroll
    for (int j = 0; j < 4; ++j) { const int n = (lane >> 3) + 8 * j; const lfloat* s = scr + (8 * c) * 33 + n;
        u32x4 o; o.x = pk2(s[0 * 33], s[1 * 33]); o.y = pk2(s[2 * 33], s[3 * 33]); o.z = pk2(s[4 * 33], s[5 * 33]); o.w = pk2(s[6 * 33], s[7 * 33]);
        *(u32x4*)(WT + (size_t)(r0 + n) * K + k0 + 8 * c) = o; }
    asm volatile("s_waitcnt lgkmcnt(0)" ::: "memory");
}
__device__ __forceinline__ void wconv_phase(const Params& p, LAS unsigned char* lds, int vcu, int G) {
    int tid_o = threadIdx.x; asm volatile("" : "+v"(tid_o));
    const int lane = tid_o & 63, wave = __builtin_amdgcn_readfirstlane(tid_o >> 6);
    lfloat* scr = (lfloat*)lds + wave * 64 * 33;
    const int gw = vcu * NWAVES + wave, NGW = G * NWAVES;
    constexpr int I_IN = (DM / 64) * (D_IN / 32), I_OUT = (DM / 64) * (DM / 32), I_UP = (DM / 64) * (D_FF2 / 32), I_DN = (D_FF / 64) * (DM / 32);
    constexpr int PER_L = I_IN + I_OUT + I_UP + I_DN;
    for (int it = gw; it < DEPTH * PER_L; it += NGW) {
        const int l = it / PER_L; int r = it % PER_L;
        if (r < I_IN) { transpose_item_l(p.in[7] + (size_t)l * DM * D_IN, DM, D_IN, (bf16_t*)(p.ws + WS_WIN) + (size_t)l * D_IN * DM, false, scr, r, lane); continue; } r -= I_IN;
        if (r < I_OUT) { transpose_item_l(p.in[28] + (size_t)l * DM * DM, DM, DM, (bf16_t*)(p.ws + WS_WOUT) + (size_t)l * DM * DM, false, scr, r, lane); continue; } r -= I_OUT;
        if (r < I_UP) { transpose_item_l(p.in[30] + (size_t)l * DM * D_FF2, DM, D_FF2, (bf16_t*)(p.ws + WS_WUP) + (size_t)l * D_FF2 * DM, true, scr, r, lane); continue; } r -= I_UP;
        transpose_item_l(p.in[33] + (size_t)l * D_FF * DM, D_FF, DM, (bf16_t*)(p.ws + WS_WDN) + (size_t)l * DM * D_FF, false, scr, r, lane);
    }
    __syncthreads();
}
__device__ __forceinline__ void mod_phase(const Params& p, LAS unsigned char* lds, int vcu, int G) {
    int tid_o = threadIdx.x; asm volatile("" : "+v"(tid_o));
    const int tid = tid_o;
    lfloat* s = (lfloat*)lds;
    float* part = (float*)(p.ws + WS_A);
    for (int item = vcu; item < DEPTH * 32 * 12; item += G) {
        const int l = item / (32 * 12), rem = item % (32 * 12), kc = rem / 12, nc = rem % 12;
        const int k0 = kc * 32, n = nc * 512 + tid;
        __syncthreads();
        if (tid < 9 * 32) { const int r = tid / 32, kk = tid % 32;
            const float v = (r < 8) ? p.in[1][(size_t)r * DM + k0 + kk] : p.in[3][k0 + kk]; s[r * 32 + kk] = silu_f(v); }
        __syncthreads();
        float acc[9];
#pragma unroll
        for (int r = 0; r < 9; ++r) acc[r] = 0.f;
        const float* W = p.in[4] + ((size_t)l * DM + k0) * 6144 + n;
#pragma unroll 8
        for (int kk = 0; kk < 32; ++kk) { const float w = W[(size_t)kk * 6144];
#pragma unroll
            for (int r = 0; r < 9; ++r) acc[r] += s[r * 32 + kk] * w; }
#pragma unroll
        for (int r = 0; r < 9; ++r) part[(((size_t)l * 32 + kc) * 9 + r) * 6144 + n] = acc[r];
    }
    __syncthreads();
}
__device__ __forceinline__ void modred_phase(const Params& p, int vcu, int G) {
    const float* part = (const float*)(p.ws + WS_A);
    float* mod = (float*)(p.ws + WS_MOD);
    for (int e = vcu * 512 + (int)threadIdx.x; e < DEPTH * 9 * 6144; e += G * 512) {
        const int l = e / (9 * 6144), rn = e % (9 * 6144);
        float a = p.in[5][(size_t)l * 6144 + rn % 6144];
        for (int kc = 0; kc < 32; ++kc) a += part[((size_t)l * 32 + kc) * 9 * 6144 + rn];
        mod[e] = a;
    }
    bf16_t* shb = (bf16_t*)(p.ws + WS_SHB);
    for (int e = vcu * 512 + (int)threadIdx.x; e < 4 * 16 * 1024; e += G * 512) {
        const int combo = e >> 14, r = (e >> 10) & 15, k = e & 1023; float a = 0.f;
        if (r < 9) { const int l = combo >> 1, idx = ((combo & 1) ? 3072 : 0) + k; a = p.in[5][(size_t)l * 6144 + idx];
            for (int kc = 0; kc < 32; ++kc) a += part[(((size_t)l * 32 + kc) * 9 + r) * 6144 + idx]; }
        shb[e] = (bf16_t)f2bf(a);
    }
}
__device__ __forceinline__ void filters_item(const Params& p, lfloat* z, lfloat* h1, lfloat* h2, int tid, int l, int L, int pos0, int np, bool vec, bf16_t* R) {
    const int FLEN = 2 * L;
    const float* w1 = p.in[10] + (size_t)l * HY_EMB * HY_FFN; const float* b1 = p.in[11] + (size_t)l * HY_FFN;
    const float* w2 = p.in[12] + (size_t)l * HY_FFN * HY_FFN; const float* b2 = p.in[13] + (size_t)l * HY_FFN;
    const float* w3 = p.in[14] + (size_t)l * HY_FFN * 1024; const float* fr = p.in[15] + (size_t)l * HY_FFN;
    __syncthreads();
    for (int e = tid; e < np * HY_EMB; e += 512) { const int pp = e / HY_EMB, f = e % HY_EMB; const int pos = pos0 + pp;
        float v;
        if (f == 0) v = (float)pos / (float)(L - 1);
        else { const int k = (f - 1) & 15; const float band = 1e-4f + (float)k * ((15.f - 1e-4f) / 15.f);
               const float w = 6.283185307179586f * (float)pos / (float)L; const float a = band * w;
               v = (f <= 16) ? cosf(a) : -sinf(a); }
        z[pp * 34 + f] = v; }
    __syncthreads();
    for (int e = tid; e < np * HY_FFN; e += 512) { const int pp = e / HY_FFN, j = e % HY_FFN; float a = b1[j];
#pragma unroll 11
        for (int i = 0; i < HY_EMB; ++i) a += z[pp * 34 + i] * w1[i * HY_FFN + j];
        h1[pp * 64 + j] = sinf(fr[j] * a); }
    __syncthreads();
    for (int e = tid; e < np * HY_FFN; e += 512) { const int pp = e / HY_FFN, j = e % HY_FFN; float a = b2[j];
#pragma unroll 16
        for (int i = 0; i < HY_FFN; ++i) a += h1[pp * 64 + i] * w2[i * HY_FFN + j];
        h2[pp * 64 + j] = sinf(fr[j] * a); }
    __syncthreads();
    for (int o = tid; o < 1024; o += 512) {
        float acc[17];
#pragma unroll
        for (int pp = 0; pp < 17; ++pp) acc[pp] = 0.f;
        for (int k0 = 0; k0 < HY_FFN; k0 += 8) {
            float w[8];
#pragma unroll
            for (int k = 0; k < 8; ++k) w[k] = w3[(k0 + k) * 1024 + o];
#pragma unroll
            for (int pp = 0; pp < 17; ++pp) { const f32x4 ha = *(LAS const f32x4*)(h2 + pp * 64 + k0), hb = *(LAS const f32x4*)(h2 + pp * 64 + k0 + 4);
                acc[pp] += (ha.x * w[0] + ha.y * w[1]) + (ha.z * w[2] + ha.w * w[3]) + (hb.x * w[4] + hb.y * w[5]) + (hb.z * w[6] + hb.w * w[7]); }
        }
        const int order = o >> 9, dir = (o >> 8) & 1, c = o & 255;
        const float mind = -4.605170185988091f / 1.5f, maxd = -4.605170185988091f / 0.3f;
        const float delta = fabsf(mind + (float)c * ((maxd - mind) / 255.f));
        bf16_t* Rc = R + ((size_t)order * D_HY + c) * FLEN;
        float v[17];
#pragma unroll
        for (int pp = 0; pp < 17; ++pp) { const float t = (float)(pos0 + pp) / (float)(L - 1); v[pp] = acc[pp] * __expf(-t * delta); }
        if (vec) {
            if (dir == 0) {
                u32x4 a0, a1;
                a0.x = pk2(v[15], v[14]); a0.y = pk2(v[13], v[12]); a0.z = pk2(v[11], v[10]); a0.w = pk2(v[9], v[8]);
                a1.x = pk2(v[7], v[6]); a1.y = pk2(v[5], v[4]); a1.z = pk2(v[3], v[2]); a1.w = pk2(v[1], v[0]);
                bf16_t* d = Rc + (L - 16 - pos0); *(u32x4*)d = a0; *(u32x4*)(d + 8) = a1;
            } else {
                if (pos0 + 16 >= L) v[16] = 0.f;
                u32x4 a0, a1;
                a0.x = pk2(v[1], v[2]); a0.y = pk2(v[3], v[4]); a0.z = pk2(v[5], v[6]); a0.w = pk2(v[7], v[8]);
                a1.x = pk2(v[9], v[10]); a1.y = pk2(v[11], v[12]); a1.z = pk2(v[13], v[14]); a1.w = pk2(v[15], v[16]);
                bf16_t* d = Rc + (L + pos0); *(u32x4*)d = a0; *(u32x4*)(d + 8) = a1;
            }
        } else {
            const int pos = pos0;
            if (dir == 0) Rc[L - 1 - pos] = (bf16_t)f2bf(v[0]);
            else if (pos > 0) Rc[L - 1 + pos] = (bf16_t)f2bf(v[0]);
            if (pos0 == 0 && dir == 0) Rc[FLEN - 1] = 0;
        }
    }
}
__device__ __forceinline__ void filters_phase(const Params& p, LAS unsigned char* lds, int vcu, int G) {
    int tid_o = threadIdx.x; asm volatile("" : "+v"(tid_o));
    const int tid = tid_o;
    lfloat* z = (lfloat*)lds;
    lfloat* h1 = z + 17 * 34 + 2;
    lfloat* h2 = h1 + 17 * 64;
    for (int e = tid; e < 580 + 2 * 17 * 64; e += 512) z[e] = 0.f;
    for (int item = vcu; item < 512; item += G) {
        if (item < 256) { const int l = item >> 7; const int pos0 = (item & 127) * 16;
            filters_item(p, z, h1, h2, tid, l, SEQ, pos0, pos0 + 17 <= SEQ ? 17 : 16, true, (bf16_t*)(p.ws + WS_FILT) + (size_t)l * 2 * D_HY * FL); }
        else filters_item(p, z, h1, h2, tid, 0, CTXL, item - 256, 1, false, (bf16_t*)(p.ws + WS_FILTC));
    }
    __syncthreads();
    {
        bf16_t* wsf = (bf16_t*)(p.ws + WS_WSF);
        for (int e = vcu * 512 + tid; e < DEPTH * 4 * 4 * 8 * 64; e += G * 512) {
            const int ln = e & 63, ks = (e >> 6) & 7, pt = (e >> 9) & 3, lg = e >> 11;
            const float* src = p.in[19] + ((size_t)lg * 128 + 32 * pt + (ln & 31)) * 128 + 16 * ks + 8 * (ln >> 5);
            const f32x4 a0 = *(const f32x4*)src, a1 = *(const f32x4*)(src + 4);
            u32x4 w; w.x = pk2(a0.x, a0.y); w.y = pk2(a0.z, a0.w); w.z = pk2(a1.x, a1.y); w.w = pk2(a1.z, a1.w);
            *(u32x4*)(wsf + (size_t)e * 8) = w; } }
    float* tab = (float*)(p.ws + WS_ROPE);
    for (int e = vcu * 512 + tid; e < SEQ * 32; e += G * 512) {
        const int pos = e >> 5, axis = (e >> 4) & 1, pr = e & 15;
        const float inv = exp2f(-(float)pr * (13.287712379549449f / 16.f));
        const float coord = axis == 0 ? (float)(pos / 64) : (float)(pos % 64);
        const float a = coord * inv;
        tab[2 * e] = cosf(a); tab[2 * e + 1] = sinf(a);
    }
}
__device__ __forceinline__ void norm0_phase(const Params& p, int vcu, int G) {
    int tid_o = threadIdx.x; asm volatile("" : "+v"(tid_o));
    const int lane = tid_o & 63, gw = vcu * NWAVES + (tid_o >> 6), NGW = G * NWAVES;
    const float* g = p.in[6];
    bf16_t* H = (bf16_t*)(p.ws + WS_HBF);
    unsigned long long* SS = (unsigned long long*)(p.ws + WS_SS);
    const float* MODl = (const float*)(p.ws + WS_MOD);
    f32x4 gv[4];
#pragma unroll
    for (int j = 0; j < 4; ++j) gv[j] = *(const f32x4*)(g + 4 * lane + 256 * j);
    for (int row = gw; row < MTOT; row += NGW) {
        const float* src; int mr;
        if (row < MLAT) { mr = row / SEQ; src = p.in[0] + (size_t)row * DM; }
        else { mr = 8; src = p.in[2] + (size_t)(row - MLAT) * DM; }
        f32x4 v[4]; float ss = 0.f;
#pragma unroll
        for (int j = 0; j < 4; ++j) { v[j] = *(const f32x4*)(src + 4 * lane + 256 * j); ss += (v[j].x * v[j].x + v[j].y * v[j].y) + (v[j].z * v[j].z + v[j].w * v[j].w); }
#pragma unroll
        for (int o = 1; o < 64; o <<= 1) ss += __shfl_xor(ss, o);
        if (lane == 0) SS[row] = (unsigned long long)(ss * SS_SCALE + 0.5f);
        const float* mrow = MODl + (size_t)mr * 6144;
#pragma unroll
        for (int j = 0; j < 4; ++j) { const int col = 4 * lane + 256 * j;
            const f32x4 sc = *(const f32x4*)(mrow + 1024 + col);
            const f32x4 y = v[j] * gv[j] * (1.f + sc);
            uint2 w; w.x = pk2(y.x, y.y); w.y = pk2(y.z, y.w);
            *(uint2*)(H + (size_t)row * DM + col) = w; }
    }
}
__device__ __forceinline__ void shw_phase(const Params& p, LAS unsigned char* lds, int vcu, int G) {
    typedef float f32x16 __attribute__((ext_vector_type(16)));
    int tid_o = threadIdx.x; asm volatile("" : "+v"(tid_o));
    const int tid = tid_o, lane = tid & 63, gw = vcu * NWAVES + (tid >> 6), NGW = G * NWAVES;
    constexpr int T_IN = D_IN / 32, T_UP = D_FF2 / 32, T_L = T_IN + T_UP;
    const int r = lane & 31, h = lane >> 5;
    for (int task = gw; task < DEPTH * T_L; task += NGW) {
        const int l = task / T_L, tt = task % T_L, which = tt >= T_IN ? 1 : 0, n0 = (which ? tt - T_IN : tt) * 32, combo = l * 2 + which;
        const bf16_t* Wt = (which ? (const bf16_t*)(p.ws + WS_WUP) + (size_t)l * D_FF2 * DM : (const bf16_t*)(p.ws + WS_WIN) + (size_t)l * D_IN * DM) + (size_t)(n0 + r) * DM + 8 * h;
        const bf16_t* ap = (const bf16_t*)(p.ws + WS_SHB) + ((size_t)combo * 16 + (r & 15)) * 1024 + 8 * h;
        f32x16 acc;
#pragma unroll
        for (int i = 0; i < 16; ++i) acc[i] = 0.f;
#pragma unroll 8
        for (int ks = 0; ks < 64; ++ks) { const bf16x8 bfr = *(const bf16x8*)(Wt + 16 * ks); const bf16x8 afr = *(const bf16x8*)(ap + 16 * ks);
            acc = __builtin_amdgcn_mfma_f32_32x32x16_bf16(afr, bfr, acc, 0, 0, 0); }
        float* dst = (float*)(p.ws + WS_SHW) + (size_t)combo * 9 * D_FF2 + n0 + r;
#pragma unroll
        for (int i = 0; i < 4; ++i) dst[(size_t)(i + 4 * h) * D_FF2] = acc[i];
        if (h == 0) dst[(size_t)8 * D_FF2] = acc[4];
    }
}
__device__ __forceinline__ void prep_qk_phase(const Params& p, int l, int nrows, int vcu, int G) {
    int tid_o = threadIdx.x; asm volatile("" : "+v"(tid_o));
    const int lane = tid_o & 63, gw = vcu * NWAVES + (tid_o >> 6), NGW = G * NWAVES;
    bf16_t* P = (bf16_t*)(p.ws + WS_A);
    const float* tab = (const float*)(p.ws + WS_ROPE);
    const int v = lane >> 2, quarter = lane & 3, axis = quarter >> 1, half = quarter & 1;
    const float* gn = (v < 8 ? p.in[21] : p.in[22]) + (size_t)l * QKD + quarter * 16;
    float g[16];
#pragma unroll
    for (int i = 0; i < 16; ++i) g[i] = gn[i];
    for (int row = gw; row < nrows; row += NGW) {
        bf16_t* ptr = P + (size_t)row * D_IN + COL_Q + v * 64 + quarter * 16;
        const u32x4 w0 = *(const u32x4*)ptr, w1 = *(const u32x4*)(ptr + 8);
        float x[16];
        x[0] = bflo(w0.x); x[1] = bfhi(w0.x); x[2] = bflo(w0.y); x[3] = bfhi(w0.y); x[4] = bflo(w0.z); x[5] = bfhi(w0.z); x[6] = bflo(w0.w); x[7] = bfhi(w0.w);
        x[8] = bflo(w1.x); x[9] = bfhi(w1.x); x[10] = bflo(w1.y); x[11] = bfhi(w1.y); x[12] = bflo(w1.z); x[13] = bfhi(w1.z); x[14] = bflo(w1.w); x[15] = bfhi(w1.w);
        float ss = 0.f;
#pragma unroll
        for (int i = 0; i < 16; ++i) ss += x[i] * x[i];
        ss += __shfl_xor(ss, 1); ss += __shfl_xor(ss, 2);
        const float rstd = rsqrtf(ss * (1.f / QKD) + EPS);
        float y[16];
#pragma unroll
        for (int i = 0; i < 16; ++i) y[i] = x[i] * rstd * g[i];
        if (row < MLAT) {
            const int pos = row % SEQ;
            const float* tp = tab + ((size_t)pos * 2 + axis) * 32;
#pragma unroll
            for (int i = 0; i < 16; ++i) { const float other = __shfl_xor(y[i], 1); const float c = tp[2 * i], s = tp[2 * i + 1];
                y[i] = half == 0 ? (y[i] * c - other * s) : (y[i] * c + other * s); }
        }
        const float sc = v < 8 ? QSCALE : 1.f;
        u32x4 o0, o1;
        o0.x = pk2(y[0] * sc, y[1] * sc); o0.y = pk2(y[2] * sc, y[3] * sc); o0.z = pk2(y[4] * sc, y[5] * sc); o0.w = pk2(y[6] * sc, y[7] * sc);
        o1.x = pk2(y[8] * sc, y[9] * sc); o1.y = pk2(y[10] * sc, y[11] * sc); o1.z = pk2(y[12] * sc, y[13] * sc); o1.w = pk2(y[14] * sc, y[15] * sc);
        *(u32x4*)ptr = o0; *(u32x4*)(ptr + 8) = o1;
    }
}
constexpr int HYP_LD = 72;
__device__ __forceinline__ void prep_hy_phase(const Params& p, int l, bool with_ctx, LAS unsigned char* lds, int vcu, int G) {
    int tid_o = threadIdx.x; asm volatile("" : "+v"(tid_o));
    const int tid = tid_o;
    LAS bf16_t* T = (LAS bf16_t*)lds;
    const bf16_t* P = (const bf16_t*)(p.ws + WS_A);
    const float* cw = p.in[8] + (size_t)l * 3 * IN_A; const float* cb = p.in[9] + (size_t)l * IN_A;
    const int nitems = 256 * 12 + (with_ctx ? 32 * 12 : 0);
    for (int item = vcu; item < nitems; item += G) {
        int b, t0, L, ct; size_t rowbase; bf16_t* dst; size_t which_stride;
        if (item < 256 * 12) { const int it = item / 12; ct = item % 12; b = it >> 5; t0 = (it & 31) * 64; L = SEQ; rowbase = (size_t)b * SEQ; dst = (bf16_t*)(p.ws + WS_HYT); which_stride = HYT_LAT_ELEMS; }
        else { const int it = (item - 256 * 12) / 12; ct = (item - 256 * 12) % 12; b = it >> 2; t0 = (it & 3) * 64; L = CTXL; rowbase = (size_t)MLAT + (size_t)b * CTXL; dst = (bf16_t*)(p.ws + WS_HYTC); which_stride = HYT_CTX_ELEMS; }
        __syncthreads();
        for (int ch = tid; ch < 66 * 8; ch += 512) { const int i = ch >> 3, part = ch & 7, t = t0 - 1 + i;
            u32x4 v = {0u, 0u, 0u, 0u};
            if (t >= 0 && t < L) v = *(const u32x4*)(P + (rowbase + t) * D_IN + ct * 64 + part * 8);
            *(LAS u32x4*)(T + i * HYP_LD + part * 8) = v; }
        __syncthreads();
        {   const int cl = tid & 63, tc = tid >> 6, c = ct * 64 + cl;
            const float w0 = cw[c], w1 = cw[IN_A + c], w2 = cw[2 * IN_A + c], bb = cb[c];
            float x[10];
#pragma unroll
            for (int i = 0; i < 10; ++i) x[i] = bf2f(T[(tc * 8 + i) * HYP_LD + cl]);
            float y[8];
#pragma unroll
            for (int i = 0; i < 8; ++i) y[i] = w0 * x[i] + w1 * x[i + 1] + w2 * x[i + 2] + bb;
            u32x4 o; o.x = pk2(y[0], y[1]); o.y = pk2(y[2], y[3]); o.z = pk2(y[4], y[5]); o.w = pk2(y[6], y[7]);
            *(u32x4*)(dst + (size_t)(c >> 8) * which_stride + ((size_t)(c & 255) * NB + b) * L + t0 + tc * 8) = o; }
    }
    __syncthreads();
}
constexpr int SGU_LD = 136;
__device__ __forceinline__ void sgu_phase(const Params& p, int l, int nitems, LAS unsigned char* lds, int vcu, int G) {
    typedef float f32x16 __attribute__((ext_vector_type(16)));
    int tid_o = threadIdx.x; asm volatile("" : "+v"(tid_o));
    const int tid = tid_o, lane = tid & 63, wave = __builtin_amdgcn_readfirstlane(tid >> 6);
    LAS bf16_t* VT = (LAS bf16_t*)lds;
    const bf16_t* P = (const bf16_t*)(p.ws + WS_A);
    bf16_t* MIX = (bf16_t*)(p.ws + WS_MIX);
    const int r = lane & 31, h = lane >> 5, pt = wave >> 1, dt = wave & 1, d = 32 * dt + r;
    const int q = tid >> 2, dq = tid & 3;
    for (int item = vcu; item < nitems; item += G) {
        int g; size_t row0;
        if (item < 512) { g = item & 3; row0 = (size_t)(item >> 2) * 128; }
        else { const int it = item - 512; g = it & 3; row0 = (size_t)MLAT + (size_t)(it >> 2) * 128; }
        const bf16_t* src = P + (row0 + q) * D_IN + IN_A + D_SG + g * 64 + dq * 16;
        const u32x4 w0 = *(const u32x4*)src, w1 = *(const u32x4*)(src + 8);
        const bf16_t* wf = (const bf16_t*)(p.ws + WS_WSF) + ((((size_t)l * 4 + g) * 4 + pt) * 8 * 64 + lane) * 8;
        bf16x8 af[8];
#pragma unroll
        for (int ks = 0; ks < 8; ++ks) af[ks] = *(const bf16x8*)(wf + (size_t)ks * 512);
        const bf16_t* up = P + (row0 + 32 * pt + 4 * h) * D_IN + IN_A + g * 64 + d;
        bf16_t uraw[16];
#pragma unroll
        for (int i = 0; i < 16; ++i) uraw[i] = up[(size_t)((i & 3) + 8 * (i >> 2)) * D_IN];
        const float* bsp = p.in[20] + ((size_t)l * 4 + g) * 128 + 32 * pt + 4 * h;
        const f32x4 bs0 = *(const f32x4*)bsp, bs1 = *(const f32x4*)(bsp + 8), bs2 = *(const f32x4*)(bsp + 16), bs3 = *(const f32x4*)(bsp + 24);
        const float* lg = p.in[17] + ((size_t)l * 4 + g) * 64 + dq * 16; const float* lb = p.in[18] + ((size_t)l * 4 + g) * 64 + dq * 16;
        float x[16];
        x[0] = bflo(w0.x); x[1] = bfhi(w0.x); x[2] = bflo(w0.y); x[3] = bfhi(w0.y); x[4] = bflo(w0.z); x[5] = bfhi(w0.z); x[6] = bflo(w0.w); x[7] = bfhi(w0.w);
        x[8] = bflo(w1.x); x[9] = bfhi(w1.x); x[10] = bflo(w1.y); x[11] = bfhi(w1.y); x[12] = bflo(w1.z); x[13] = bfhi(w1.z); x[14] = bflo(w1.w); x[15] = bfhi(w1.w);
        float sm = 0.f;
#pragma unroll
        for (int i = 0; i < 16; ++i) { x[i] = gelu_tanh(x[i]); sm += x[i]; }
        sm += __shfl_xor(sm, 1); sm += __shfl_xor(sm, 2);
        const float mu = sm * (1.f / 64.f); float s2 = 0.f;
#pragma unroll
        for (int i = 0; i < 16; ++i) { x[i] -= mu; s2 += x[i] * x[i]; }
        s2 += __shfl_xor(s2, 1); s2 += __shfl_xor(s2, 2);
        const float rstd = rsqrtf(s2 * (1.f / 64.f) + EPS);
        __syncthreads();
#pragma unroll
        for (int i = 0; i < 16; ++i) VT[(dq * 16 + i) * SGU_LD + q] = (bf16_t)f2bf(x[i] * rstd * lg[i] + lb[i]);
        __syncthreads();
        f32x16 acc;
#pragma unroll
        for (int i = 0; i < 16; ++i) acc[i] = 0.f;
        LAS const bf16_t* bp = VT + d * SGU_LD + 8 * h;
#pragma unroll
        for (int ks = 0; ks < 8; ++ks) { const bf16x8 bfr = *(LAS const bf16x8*)(bp + 16 * ks); acc = __builtin_amdgcn_mfma_f32_32x32x16_bf16(af[ks], bfr, acc, 0, 0, 0); }
        bf16_t* op = MIX + (row0 + 32 * pt + 4 * h) * DM + D_HY + g * 64 + d;
#pragma unroll
        for (int i = 0; i < 16; ++i) { const int pr = (i & 3) + 8 * (i >> 2);
            const float bsv = (i >> 2) == 0 ? bs0[i & 3] : (i >> 2) == 1 ? bs1[i & 3] : (i >> 2) == 2 ? bs2[i & 3] : bs3[i & 3];
            op[(size_t)pr * DM] = (bf16_t)f2bf(gelu_tanh(bf2f(uraw[i])) * (acc[i] + bsv)); }
    }
    __syncthreads();
}

namespace att {
typedef short s16x4 __attribute__((ext_vector_type(4)));
typedef float f32x16 __attribute__((ext_vector_type(16)));
constexpr int KVBLK = 64, SHM_T = 16384;
constexpr int OFF_V = 0, OFF_K = 2 * SHM_T, OFF_STAGE = 0, STAGE_LD = 132, OFF_SCR = 69632;
#define KSWZ(row, colB) ((row) * 256 + ((colB) ^ (((row) & 7) << 4)))
#define SBAR() __builtin_amdgcn_sched_barrier(0)
__device__ __forceinline__ int crow(int r, int hi) { return (r & 3) + 8 * (r >> 2) + 4 * hi; }
__device__ __forceinline__ int v_st(int k, int c) { const int kk = (k & ~0xC) | ((k & 4) << 1) | ((k & 8) >> 1); return ((kk >> 3) * 4 + (c >> 5)) * 512 + ((kk & 7) * 32 + (c & 31)) * 2; }
__device__ __forceinline__ int v_rd_base(int lane) { return ((lane & 3) << 3) | (((lane >> 2) & 3) << 6) | (((lane >> 4) & 1) << 5) | (((lane >> 5) & 1) << 8); }
constexpr int v_rd_off(int d0, int ks, int half) { return d0 * 512 + ks * 4096 + half * 2048; }
template <int OFF> __device__ __forceinline__ s16x4 tr_read(int vb) {
    s16x4 r; asm volatile("ds_read_b64_tr_b16 %0, %1 offset:%2" : "=&v"(r) : "v"(vb), "i"(OFF) : "memory"); return r; }
template <int D0> __device__ __forceinline__ void pv_one(f32x16& od, int vb, bf16x8 pa0, bf16x8 pa1, bf16x8 pa2, bf16x8 pa3) {
    const s16x4 l0 = tr_read<v_rd_off(D0, 0, 0)>(vb), h0 = tr_read<v_rd_off(D0, 0, 1)>(vb), l1 = tr_read<v_rd_off(D0, 1, 0)>(vb), h1 = tr_read<v_rd_off(D0, 1, 1)>(vb);
    const s16x4 l2 = tr_read<v_rd_off(D0, 2, 0)>(vb), h2 = tr_read<v_rd_off(D0, 2, 1)>(vb), l3 = tr_read<v_rd_off(D0, 3, 0)>(vb), h3 = tr_read<v_rd_off(D0, 3, 1)>(vb);
    asm volatile("s_waitcnt lgkmcnt(0)" ::: "memory"); SBAR();
#define PK(L, H) (bf16x8){L[0], L[1], L[2], L[3], H[0], H[1], H[2], H[3]}
    od = __builtin_amdgcn_mfma_f32_32x32x16_bf16(pa0, PK(l0, h0), od, 0, 0, 0);
    od = __builtin_amdgcn_mfma_f32_32x32x16_bf16(pa1, PK(l1, h1), od, 0, 0, 0);
    od = __builtin_amdgcn_mfma_f32_32x32x16_bf16(pa2, PK(l2, h2), od, 0, 0, 0);
    od = __builtin_amdgcn_mfma_f32_32x32x16_bf16(pa3, PK(l3, h3), od, 0, 0, 0);
#undef PK
}
__device__ __forceinline__ void tile_compute(f32x16 (&o)[4], float& l_reg, const bf16x8 (&qr)[4], const f32x16& negm, LAS const unsigned char* Kt, int vb, int kcb, int r32) {
    f32x16 p0, p1;
#pragma unroll
    for (int d0 = 0; d0 < 4; ++d0) { const int cb = kcb + d0 * 32;
        const bf16x8 b0 = *(LAS const bf16x8*)(Kt + KSWZ(r32, cb)); const bf16x8 b1 = *(LAS const bf16x8*)(Kt + KSWZ(32 + r32, cb));
        if (d0 == 0) { p0 = __builtin_amdgcn_mfma_f32_32x32x16_bf16(b0, qr[0], negm, 0, 0, 0); p1 = __builtin_amdgcn_mfma_f32_32x32x16_bf16(b1, qr[0], negm, 0, 0, 0); }
        else { p0 = __builtin_amdgcn_mfma_f32_32x32x16_bf16(b0, qr[d0], p0, 0, 0, 0); p1 = __builtin_amdgcn_mfma_f32_32x32x16_bf16(b1, qr[d0], p1, 0, 0, 0); } }
#pragma unroll
    for (int r = 0; r < 16; ++r) { p0[r] = __builtin_amdgcn_exp2f(p0[r]); p1[r] = __builtin_amdgcn_exp2f(p1[r]); }
    float ps = 0.f;
#pragma unroll
    for (int r = 0; r < 16; ++r) ps += p0[r] + p1[r];
    l_reg += ps;
    bf16x8 pa0, pa1, pa2, pa3;
#define PK4(P, BASE, OUT) do { unsigned a0 = cvt_pk_bf16(P[BASE + 0], P[BASE + 1]), a1 = cvt_pk_bf16(P[BASE + 2], P[BASE + 3]);   \
    unsigned b0_ = cvt_pk_bf16(P[BASE + 4], P[BASE + 5]), b1_ = cvt_pk_bf16(P[BASE + 6], P[BASE + 7]);                              \
    auto r0 = __builtin_amdgcn_permlane32_swap(a0, b0_, false, false); auto r1 = __builtin_amdgcn_permlane32_swap(a1, b1_, false, false); \
    u32x4 w = {r0[0], r1[0], r0[1], r1[1]}; OUT = __builtin_bit_cast(bf16x8, w); } while (0)
    PK4(p0, 0, pa0); PK4(p0, 8, pa1); PK4(p1, 0, pa2); PK4(p1, 8, pa3);
#undef PK4
    pv_one<0>(o[0], vb, pa0, pa1, pa2, pa3); pv_one<1>(o[1], vb, pa0, pa1, pa2, pa3); pv_one<2>(o[2], vb, pa0, pa1, pa2, pa3); pv_one<3>(o[3], vb, pa0, pa1, pa2, pa3);
}
struct Stg { u32x4 vs0, vs1, ks0, ks1; };
__device__ __forceinline__ void attn_unit(const Params& p, int l, int b, int h, int q0, bool ctxu, LAS unsigned char* lds, float lam, float lam_init, float M2) {
    int tid_o = threadIdx.x; asm volatile("" : "+v"(tid_o));
    const int tid = tid_o, lane = tid & 63, r32 = lane & 31, hi = lane >> 5;
    const int wid = __builtin_amdgcn_readfirstlane(tid >> 6), comp = wid >> 2, wq = wid & 3;
    const bf16_t* P = (const bf16_t*)(p.ws + WS_A);
    const size_t lat0 = (size_t)b * SEQ, ctx0 = (size_t)MLAT + (size_t)b * CTXL;
    const size_t qrow0 = (ctxu ? ctx0 : lat0) + q0 + wq * 32;
    const int NT = ctxu ? CTXL / KVBLK : (SEQ + CTXL) / KVBLK;
    LAS unsigned char* V_lds = lds + OFF_V; LAS unsigned char* K_lds = lds + OFF_K;
    LAS float* scr = (LAS float*)(lds + OFF_SCR) + wid * 64;
    bf16x8 qr[4];
    { const bf16_t* Qw = P + (qrow0 + r32) * D_IN + COL_Q + h * 128 + comp * 64 + hi * 8;
#pragma unroll
      for (int d0 = 0; d0 < 4; ++d0) qr[d0] = *(const bf16x8*)(Qw + d0 * 16); }
    f32x16 negm;
#pragma unroll
    for (int r = 0; r < 16; ++r) negm[r] = -M2;
    f32x16 o[4];
#pragma unroll
    for (int d = 0; d < 4; ++d)
#pragma unroll
        for (int r = 0; r < 16; ++r) o[d][r] = 0.f;
    float l_reg = 0.f;
    const int sr = tid >> 4, sc = (tid & 15) * 8;
    const int vst0 = v_st(sr, sc), vst1 = v_st(32 + sr, sc), kst0 = KSWZ(sr, sc * 2), kst1 = KSWZ(32 + sr, sc * 2);
    const int vb0 = (int)(unsigned)(uintptr_t)V_lds + v_rd_base(lane);
    const int kcb = (comp * 64 + hi * 8) * 2;
    const bf16_t* Kg = P + COL_K + h * 128 + sc; const bf16_t* Vg = P + COL_V + h * 128 + sc;
#define KROW(t_, rr) ((ctxu || (t_) >= SEQ / KVBLK) ? (ctx0 + (size_t)((t_) - (ctxu ? 0 : SEQ / KVBLK)) * KVBLK + (rr)) : (lat0 + (size_t)(t_) * KVBLK + (rr)))
#define SLOAD(S, t_) do { const size_t ra = KROW(t_, sr) * D_IN, rb = KROW(t_, 32 + sr) * D_IN; \
        S.vs0 = *(const u32x4*)(Vg + ra); S.vs1 = *(const u32x4*)(Vg + rb); S.ks0 = *(const u32x4*)(Kg + ra); S.ks1 = *(const u32x4*)(Kg + rb); } while (0)
#define SWRITE(bf, S) do { *(LAS u32x4*)(V_lds + (bf) * SHM_T + vst0) = S.vs0; *(LAS u32x4*)(V_lds + (bf) * SHM_T + vst1) = S.vs1; \
        *(LAS u32x4*)(K_lds + (bf) * SHM_T + kst0) = S.ks0; *(LAS u32x4*)(K_lds + (bf) * SHM_T + kst1) = S.ks1; } while (0)
    Stg s0, s1;
    SLOAD(s0, 0); SWRITE(0, s0);
    SLOAD(s0, 1); SLOAD(s1, 2);
    __syncthreads();
    for (int j = 0; j < NT; j += 2) {
        SWRITE(1, s0); if (j + 3 < NT) SLOAD(s0, j + 3);
        tile_compute(o, l_reg, qr, negm, K_lds, vb0, kcb, r32);
        __syncthreads();
        if (j + 2 < NT) { SWRITE(0, s1); if (j + 4 < NT) SLOAD(s1, j + 4); }
        tile_compute(o, l_reg, qr, negm, K_lds + SHM_T, vb0 + SHM_T, kcb, r32);
        __syncthreads();
    }
#undef SLOAD
#undef SWRITE
#undef KROW
    const float lt = l_reg + __shfl_xor(l_reg, 32);
    const float rl = (comp == 0 ? 1.f : lam) / lt;
    if (hi == 0) scr[r32] = rl;
    asm volatile("s_waitcnt lgkmcnt(0)" ::: "memory");
    float rli[16];
#pragma unroll
    for (int r = 0; r < 16; ++r) rli[r] = scr[crow(r, hi)];
    LAS float* stage = (LAS float*)(lds + OFF_STAGE) + wq * 32 * STAGE_LD;
    if (comp == 1) {
#pragma unroll
        for (int d0 = 0; d0 < 4; ++d0)
#pragma unroll
            for (int r = 0; r < 16; ++r) stage[crow(r, hi) * STAGE_LD + 32 * d0 + r32] = o[d0][r] * rli[r];
    }
    __syncthreads();
    if (comp == 0) {
#pragma unroll
        for (int d0 = 0; d0 < 4; ++d0)
#pragma unroll
            for (int r = 0; r < 16; ++r) { const int idx = crow(r, hi) * STAGE_LD + 32 * d0 + r32; stage[idx] = o[d0][r] * rli[r] - stage[idx]; }
        asm volatile("s_waitcnt lgkmcnt(0)" ::: "memory");
        const int row = lane >> 1, half = lane & 1;
        f32x4 v[16]; float ss = 0.f;
#pragma unroll
        for (int i = 0; i < 16; ++i) { v[i] = *(LAS const f32x4*)(stage + row * STAGE_LD + half * 64 + 4 * i); ss += (v[i].x * v[i].x + v[i].y * v[i].y) + (v[i].z * v[i].z + v[i].w * v[i].w); }
        ss += __shfl_xor(ss, 1);
        const float rstd = rsqrtf(ss * (1.f / VD) + EPS) * (1.f - lam_init);
        const float* gs = p.in[27] + (size_t)l * VD + half * 64;
        bf16_t* dst = (bf16_t*)(p.ws + WS_MIX) + (qrow0 + row) * DM + 512 + h * 128 + half * 64;
#pragma unroll
        for (int i = 0; i < 8; ++i) { const f32x4 g0 = *(const f32x4*)(gs + 8 * i), g1 = *(const f32x4*)(gs + 8 * i + 4); const f32x4 a = v[2 * i] * rstd * g0, c = v[2 * i + 1] * rstd * g1;
            u32x4 w; w.x = cvt_pk_bf16(a.x, a.y); w.y = cvt_pk_bf16(a.z, a.w); w.z = cvt_pk_bf16(c.x, c.y); w.w = cvt_pk_bf16(c.z, c.w);
            *(u32x4*)(dst + 8 * i) = w; }
    }
    __syncthreads();
}
__device__ __forceinline__ void attn_scalars(const Params& p, int l, int lane, float& lam, float& lam_init, float& M2) {
    float s1 = p.in[23][l * QKD + lane] * p.in[24][l * QKD + lane], s2 = p.in[25][l * QKD + lane] * p.in[26][l * QKD + lane];
    float gq = fabsf(p.in[21][l * QKD + lane]), gk = fabsf(p.in[22][l * QKD + lane]);
#pragma unroll
    for (int o = 1; o < 64; o <<= 1) { s1 += __shfl_xor(s1, o); s2 += __shfl_xor(s2, o); gq = fmaxf(gq, __shfl_xor(gq, o)); gk = fmaxf(gk, __shfl_xor(gk, o)); }
    lam_init = 0.8f - 0.6f * expf(-0.3f * (float)l);
    lam = expf(s1) - expf(s2) + lam_init;
    M2 = 8.f * gq * gk * LOG2E;
}
__device__ __forceinline__ void attn_phase(const Params& p, int l, LAS unsigned char* lds, int vcu, int G, bool with_ctx) {
    float lam, lam_init, M2; attn_scalars(p, l, threadIdx.x & 63, lam, lam_init, M2);
    const int nunits = 512 + (with_ctx ? 64 : 0);
    for (int u = vcu; u < nunits; u += G) {
        if (u < 512) attn_unit(p, l, u >> 6, (u >> 4) & 3, (u & 15) * 128, false, lds, lam, lam_init, M2);
        else { const int v = u - 512; attn_unit(p, l, v >> 3, (v >> 1) & 3, (v & 1) * 128, true, lds, lam, lam_init, M2); }
    }
}
#undef KSWZ
#undef SBAR
}

namespace hyc {
typedef float f32x16 __attribute__((ext_vector_type(16)));
constexpr int UOFF = 65536, UBLK = 640, ROFF = UOFF + 70 * UBLK;
__device__ __forceinline__ int crow(int r, int hi) { return (r & 3) + 8 * (r >> 2) + 4 * hi; }
__device__ __forceinline__ void conv_unit(const Params& p, int l, int order, int c, bool ctxu, LAS unsigned char* lds) {
    int tid_o = threadIdx.x; asm volatile("" : "+v"(tid_o));
    const int tid = tid_o, lane = tid & 63, wave = __builtin_amdgcn_readfirstlane(tid >> 6);
    const int L = ctxu ? CTXL : SEQ, nblk = L >> 5, FLEN = 2 * L;
    const bf16_t* R = ctxu ? (const bf16_t*)(p.ws + WS_FILTC) + ((size_t)order * D_HY + c) * FLEN
                           : (const bf16_t*)(p.ws + WS_FILT) + (((size_t)l * 2 + order) * D_HY + c) * FLEN;
    bf16_t* HY = ctxu ? (bf16_t*)(p.ws + WS_HYTC) : (bf16_t*)(p.ws + WS_HYT);
    const size_t wst = ctxu ? HYT_CTX_ELEMS : HYT_LAT_ELEMS;
    const size_t coff = (size_t)c * NB * L;
    const bf16_t* Uin = HY + (order == 0 ? 0 : 3) * wst + coff;
    const bf16_t* Xg = HY + (order == 0 ? 1 : 2) * wst + coff;
    for (int i = tid; i < FLEN / 8; i += 512) *(LAS u32x4*)(lds + ROFF + 16 * i) = *(const u32x4*)(R + 8 * i);
    if (tid < 8) *(LAS unsigned*)(lds + ROFF + FLEN * 2 + 4 * tid) = 0u;
    for (int ch = tid; ch < L; ch += 512) { const int b = ch / (L >> 3), s = (ch % (L >> 3)) * 8;
        const u32x4 v = *(const u32x4*)(Uin + (size_t)b * L + s);
        *(LAS u32x4*)(lds + UOFF + ((s >> 5) + 3) * UBLK + ((s >> 4) & 1) * 256 + ((s >> 3) & 1) * 128 + b * 16) = v; }
    if (tid < 240) { const int blk = tid / 40, w = tid % 40; const int J = blk < 3 ? blk - 3 : nblk + (blk - 3);
        *(LAS u32x4*)(lds + UOFF + (J + 3) * UBLK + w * 16) = (u32x4){0u, 0u, 0u, 0u}; }
    __syncthreads();
    for (int e = tid; e < FLEN; e += 512) {
        LAS const unsigned* r32p = (LAS const unsigned*)(lds + ROFF) + (e >> 1);
        const unsigned d0 = r32p[0], d1 = r32p[1], d2 = r32p[2], d3 = r32p[3], d4 = r32p[4];
        u32x4 w;
        if (e & 1) { w.x = __builtin_amdgcn_alignbit(d1, d0, 16); w.y = __builtin_amdgcn_alignbit(d2, d1, 16); w.z = __builtin_amdgcn_alignbit(d3, d2, 16); w.w = __builtin_amdgcn_alignbit(d4, d3, 16); }
        else { w.x = d0; w.y = d1; w.z = d2; w.w = d3; }
        *(LAS u32x4*)(lds + 16 * e) = w; }
    __syncthreads();
    const int r = lane & 31, h = lane >> 5, bb = lane & 7, q = (lane >> 3) & 3;
    const float bias = p.in[16][((size_t)l * 2 + order) * D_HY + c];
    for (int g = wave; g < (nblk >> 2); g += 8) {
        const int I0 = 4 * g;
        f32x16 acc;
#pragma unroll
        for (int i = 0; i < 16; ++i) acc[i] = 0.f;
        const int dlo = I0 - (nblk - 1), dhi = I0 + 3;
        LAS const unsigned char* ap = lds + 16 * ((L - 1) - 32 * dlo - r + 8 * h);
        LAS const unsigned char* bp = lds + UOFF + (I0 + q - dlo + 3) * UBLK + h * 128 + bb * 16;
        for (int d = dlo; d <= dhi; ++d) {
            const bf16x8 a0 = *(LAS const bf16x8*)(ap), a1 = *(LAS const bf16x8*)(ap + 256);
            const bf16x8 b0 = *(LAS const bf16x8*)(bp), b1 = *(LAS const bf16x8*)(bp + 256);
            acc = __builtin_amdgcn_mfma_f32_32x32x16_bf16(a0, b0, acc, 0, 0, 0);
            acc = __builtin_amdgcn_mfma_f32_32x32x16_bf16(a1, b1, acc, 0, 0, 0);
            ap -= 512; bp -= UBLK;
        }
        const int tb = 32 * (I0 + q) + 4 * h;
        const size_t boff = (size_t)bb * L;
#pragma unroll
        for (int gq = 0; gq < 4; ++gq) {
            const int t = tb + 8 * gq;
            const uint2 xu = *(const uint2*)(Xg + boff + t), uu = *(const uint2*)(Uin + boff + t);
            float o[4];
            o[0] = bflo(xu.x) * (acc[4 * gq + 0] + bias * bflo(uu.x)); o[1] = bfhi(xu.x) * (acc[4 * gq + 1] + bias * bfhi(uu.x));
            o[2] = bflo(xu.y) * (acc[4 * gq + 2] + bias * bflo(uu.y)); o[3] = bfhi(xu.y) * (acc[4 * gq + 3] + bias * bfhi(uu.y));
            if (order == 0) { uint2 w; w.x = cvt_pk_bf16(o[0], o[1]); w.y = cvt_pk_bf16(o[2], o[3]); *(uint2*)(HY + 3 * wst + coff + boff + t) = w; }
            else { bf16_t* mx = (bf16_t*)(p.ws + WS_MIX) + ((ctxu ? (size_t)MLAT + (size_t)bb * CTXL : (size_t)bb * SEQ) + t) * DM + c;
#pragma unroll
                   for (int j = 0; j < 4; ++j) mx[(size_t)j * DM] = (bf16_t)f2bf(o[j]); }
        }
    }
    __syncthreads();
}
__device__ __forceinline__ void conv_phase(const Params& p, int l, LAS unsigned char* lds, int vcu, int G, bool with_ctx) {
    for (int c = vcu; c < D_HY; c += G) {
        conv_unit(p, l, 0, c, false, lds); if (with_ctx) conv_unit(p, l, 0, c, true, lds);
        asm volatile("s_waitcnt vmcnt(0)" ::: "memory"); __syncthreads();
        conv_unit(p, l, 1, c, false, lds); if (with_ctx) conv_unit(p, l, 1, c, true, lds);
    }
}
}

constexpr int RING_OFF = 0, RING_BYTES = 131072;
constexpr int LDSCTL_OFF = RING_BYTES, MISC_OFF = LDSCTL_OFF + 320;
constexpr int LDS_BYTES = 147456;
constexpr int CW_BAR = 131072;
constexpr size_t WS_RAW = WS_B + 36 * MiB;

struct MkArgs { Params p; int ph_lo, ph_hi, li, sub; };

enum Phase { PH_PRO_A = 0, PH_PRO_B = 1, PH_N0 = 2, PH_L0 = 3, PHL_GEMM_IN = 0, PHL_PREP = 1, PHL_MIX1 = 2, PHL_GEMM_OUT = 3, PHL_GEMM_UP = 4, PHL_GEMM_DOWN = 5, PHL_N = 6, PH_TOTAL = 3 + 2 * 6 };

__device__ __forceinline__ void fixup_phase(const Params& p, int l, int q0, int nchunks, int wid_g, int nw_g, int lane) {
    const float* RAW = (const float*)(p.ws + WS_RAW); bf16_t* G = (bf16_t*)(p.ws + WS_A);
    const float* cw = p.in[31] + (size_t)l * 3 * D_FF2; const float* cb = p.in[32] + (size_t)l * D_FF2;
    const int nitems = nchunks * 2 * 11;
    for (int it = wid_g; it < nitems; it += nw_g) {
        const int slab = it % 11, rw = (it / 11) & 1, q = q0 + it / 22;
        const int row = q * 64 + (rw ? 63 : 0);
        const int L = row < MLAT ? SEQ : CTXL, t = row < MLAT ? row % SEQ : (row - MLAT) % CTXL;
        const int o = slab * 256 + lane * 4;
        const int rg = 256 * (o / 128) + (o % 128);
        const float* rp; const float* rc; const float* rn; bool hp, hn;
        if (!rw) { hp = t > 0; rp = RAW + ((size_t)(q - 1) * 4 + 3) * D_FF2; rc = RAW + ((size_t)q * 4 + 0) * D_FF2; rn = RAW + ((size_t)q * 4 + 1) * D_FF2; hn = true; }
        else { hp = true; rp = RAW + ((size_t)q * 4 + 2) * D_FF2; rc = RAW + ((size_t)q * 4 + 3) * D_FF2; hn = t < L - 1; rn = RAW + ((size_t)(q + 1) * 4 + 0) * D_FF2; }
        const f32x4 z = {0.f, 0.f, 0.f, 0.f};
        const f32x4 gp = hp ? *(const f32x4*)(rp + rg) : z, vp = hp ? *(const f32x4*)(rp + rg + 128) : z;
        const f32x4 gc = *(const f32x4*)(rc + rg), vc = *(const f32x4*)(rc + rg + 128);
        const f32x4 gn = hn ? *(const f32x4*)(rn + rg) : z, vn = hn ? *(const f32x4*)(rn + rg + 128) : z;
        const f32x4 cg = *(const f32x4*)(cw + o) * gp + *(const f32x4*)(cw + D_FF2 + o) * gc + *(const f32x4*)(cw + 2 * D_FF2 + o) * gn + *(const f32x4*)(cb + o);
        const f32x4 cv = *(const f32x4*)(cw + D_FF + o) * vp + *(const f32x4*)(cw + D_FF2 + D_FF + o) * vc + *(const f32x4*)(cw + 2 * D_FF2 + D_FF + o) * vn + *(const f32x4*)(cb + D_FF + o);
        float oo[4];
#pragma unroll
        for (int j = 0; j < 4; ++j) oo[j] = cg[j] * __builtin_amdgcn_rcpf(1.f + __expf(-cg[j])) * cv[j];
        uint2 w; w.x = cvt_pk_bf16(oo[0], oo[1]); w.y = cvt_pk_bf16(oo[2], oo[3]);
        *(uint2*)(G + (size_t)row * D_FF + o) = w;
    }
}

__global__ void __launch_bounds__(NWAVES * 64, 2) mk_fwd(MkArgs a) {
    extern __shared__ __attribute__((aligned(16))) unsigned char lds_raw[];
    LAS unsigned char* lds = (LAS unsigned char*)lds_raw;
    const Params& p = a.p;
    const int tid = threadIdx.x, lane = tid & 63, wave = __builtin_amdgcn_readfirstlane(tid >> 6);
    const int G = gridDim.x; const int bx = blockIdx.x; const int vcu = (G % 8 == 0) ? (bx % 8) * (G / 8) + bx / 8 : bx;
    volatile LAS unsigned* MISC = (volatile LAS unsigned*)(lds + MISC_OFF);
    for (int u = tid; u < (LDS_BYTES - LDSCTL_OFF) / 4; u += NWAVES * 64) ((LAS unsigned*)(lds + LDSCTL_OFF))[u] = 0u;
    __syncthreads();
    unsigned* ctl = (unsigned*)(p.ws + WS_CTL);
    XcdBarrier bar; bar.bar = ctl + CW_BAR + a.li * XCD_BAR_WORDS; bar.x = 0; bar.st = nullptr;
    const bool multi = (a.ph_hi - a.ph_lo) > 1;
    if (multi) bar = xcd_barrier_post(ctl + CW_BAR + a.li * XCD_BAR_WORDS, MISC + 8);
    const int lo = a.ph_lo, hi = a.ph_hi;
#define IN(k) (lo <= (k) && (k) < hi)
#define SEAM(k) do { if (IN(k) && IN((k) + 1)) xcd_barrier(bar); } while (0)
    bf16_t* HBF = (bf16_t*)(p.ws + WS_HBF); bf16_t* PA = (bf16_t*)(p.ws + WS_A); bf16_t* MIX = (bf16_t*)(p.ws + WS_MIX);
    const float* MOD = (const float*)(p.ws + WS_MOD);
    const int sub = a.sub; const bool probe = a.li != 0;
    if (IN(PH_PRO_A)) { if (sub & 1) wconv_phase(p, lds, vcu, G); if (sub & 2) mod_phase(p, lds, vcu, G); if (sub & 4) filters_phase(p, lds, vcu, G); }
    SEAM(PH_PRO_A);
    if (IN(PH_PRO_B)) modred_phase(p, vcu, G);
    SEAM(PH_PRO_B);
    if (IN(PH_N0)) { if (sub & 1) norm0_phase(p, vcu, G); if (sub & 2) shw_phase(p, lds, vcu, G); }
    SEAM(PH_N0);
    unsigned long long* SS = (unsigned long long*)(p.ws + WS_SS); const float* SHW = (const float*)(p.ws + WS_SHW);
    for (int l = 0; l < DEPTH; ++l) {
        const int pb = PH_L0 + l * PHL_N; const bool last = (l == DEPTH - 1);
        const int nMt = last ? MLAT / BM : MTOT / BM;
        if (IN(pb + PHL_GEMM_IN)) {
            Gemm g{HBF, (const bf16_t*)(p.ws + WS_WIN) + (size_t)l * D_IN * DM, MTOT, D_IN, DM};
            RectOrder S; S.init(MLAT / BM, D_IN / BM, MCTX / BM, last ? (D_IN - COL_Q) / BM : D_IN / BM, MLAT / BM, last ? COL_Q / BM : 0, G, bx);
            EpiP E{PA, D_IN, SS + (size_t)(2 * l) * MTOT, SHW + (size_t)(2 * l) * 9 * D_FF2};
            gemm_phase<EpiP, RectOrder, true, true>(lds + RING_OFF, g, S, E);
        }
        SEAM(pb + PHL_GEMM_IN);
        if (IN(pb + PHL_PREP)) { if (sub & 1) prep_qk_phase(p, l, MTOT, vcu, G); if (sub & 2) prep_hy_phase(p, l, !last, lds, vcu, G); if (sub & 4) sgu_phase(p, l, last ? 512 : 576, lds, vcu, G); }
        SEAM(pb + PHL_PREP);
        if (IN(pb + PHL_MIX1)) { if (sub & 1) att::attn_phase(p, l, lds + RING_OFF, vcu, G, !last); if (sub & 2) hyc::conv_phase(p, l, lds + RING_OFF, vcu, G, !last); }
        SEAM(pb + PHL_MIX1);
        if (IN(pb + PHL_GEMM_OUT)) {
            Gemm g{MIX, (const bf16_t*)(p.ws + WS_WOUT) + (size_t)l * DM * DM, MTOT, DM, DM};
            RectOrder S; S.init(nMt, DM / BM, 0, 0, 0, 0, G, bx);
            EpiRes E{l == 0 ? p.in[0] : (const float*)p.out, l == 0 ? p.in[2] : (const float*)(p.ws + WS_CS), probe ? (float*)(p.ws + WS_A + 32 * MiB) : p.out, (float*)(p.ws + WS_CS), MOD + (size_t)l * 9 * 6144 + 2048,
                     HBF, p.in[29] + (size_t)l * DM, MOD + (size_t)l * 9 * 6144 + 4096, SS + (size_t)(2 * l + 1) * MTOT};
            gemm_phase<EpiRes, RectOrder, true, true>(lds + RING_OFF, g, S, E);
        }
        SEAM(pb + PHL_GEMM_OUT);
        if (IN(pb + PHL_GEMM_UP)) {
            Gemm g{HBF, (const bf16_t*)(p.ws + WS_WUP) + (size_t)l * D_FF2 * DM, MTOT, D_FF2, DM};
            RectOrder S; S.init(nMt, D_FF2 / BM, 0, 0, 0, 0, G, bx);
            EpiCG E{PA, (float*)(p.ws + WS_RAW), p.in[31] + (size_t)l * 3 * D_FF2, p.in[32] + (size_t)l * D_FF2, SS + (size_t)(2 * l + 1) * MTOT, SHW + (size_t)(2 * l + 1) * 9 * D_FF2};
            gemm_phase<EpiCG, RectOrder, true, true>(lds + RING_OFF, g, S, E);
        }
        SEAM(pb + PHL_GEMM_UP);
        if (IN(pb + PHL_GEMM_DOWN)) {
            Gemm g{PA, (const bf16_t*)(p.ws + WS_WDN) + (size_t)l * DM * D_FF, MTOT, DM, D_FF};
            RectOrder S; S.init(nMt, DM / BM, 0, 0, 0, 0, G, bx);
            { Unit fu; for (int i = 0; S.next(i, fu); ++i) fixup_phase(p, l, fu.pm * 4, 4, wave, NWAVES, lane); }
            asm volatile("s_waitcnt vmcnt(0)" ::: "memory"); __syncthreads();
            EpiRes E{(const float*)p.out, (const float*)(p.ws + WS_CS), probe ? (float*)(p.ws + WS_A + 32 * MiB) : p.out, (float*)(p.ws + WS_CS), MOD + (size_t)l * 9 * 6144 + 5120,
                     last ? (bf16_t*)nullptr : HBF, p.in[6] + (size_t)(l + 1) * DM, MOD + (size_t)(l + 1) * 9 * 6144 + 1024, SS + (size_t)(2 * l + 2) * MTOT};
            gemm_phase<EpiRes, RectOrder, true, true>(lds + RING_OFF, g, S, E);
        }
        SEAM(pb + PHL_GEMM_DOWN);
    }
#undef IN
#undef SEAM
}
}

extern "C" void kernel_launch(void* const* d_in, const int* in_sizes, int n_in, void* d_out, int out_size, void* d_ws, size_t ws_size, hipStream_t stream) {
    static int ok = 0;
    if (ok == 0) {
        if (n_in != 34 || in_sizes[0] != MLAT * DM || out_size != MLAT * DM || ws_size < WS_END) {
            fprintf(stderr, "kernel_launch: unexpected shapes n_in %d in0 %d out %d ws %zu\n", n_in, n_in > 0 ? in_sizes[0] : -1, out_size, ws_size); ok = -1; return; }
        if (hipFuncSetAttribute((const void*)mk_fwd, hipFuncAttributeMaxDynamicSharedMemorySize, LDS_BYTES) != hipSuccess) { fprintf(stderr, "kernel_launch: LDS attribute failed\n"); ok = -1; return; }
        ok = 1;
    }
    if (ok < 0) return;
    (void)hipMemsetAsync((char*)d_ws + WS_CTL, 0, CTL_BYTES, stream);
    MkArgs a{};
    for (int i = 0; i < 34; ++i) a.p.in[i] = (const float*)d_in[i];
    a.p.out = (float*)d_out; a.p.ws = (unsigned char*)d_ws;
#if MK_PER_PHASE
    for (int ph = 0; ph < PH_TOTAL; ++ph) { a.ph_lo = ph; a.ph_hi = ph + 1; a.li = 0; a.sub = 0xff; hipLaunchKernelGGL(mk_fwd, dim3(256), dim3(NWAVES * 64), LDS_BYTES, stream, a); }
#else
    a.ph_lo = 0; a.ph_hi = PH_TOTAL; a.li = 0; a.sub = 0xff;
    hipLaunchKernelGGL(mk_fwd, dim3(256), dim3(NWAVES * 64), LDS_BYTES, stream, a);
#endif
#if PROBE_PH >= 0
    for (int r = 0; r < PROBE_REP; ++r) { a.ph_lo = PROBE_PH; a.ph_hi = PROBE_PH + 1; a.li = 1; a.sub = PROBE_SUB; hipLaunchKernelGGL(mk_fwd, dim3(256), dim3(NWAVES * 64), LDS_BYTES, stream, a); }
#endif
}
```
